# Optimizing an MI355X kernel written in HIP

```python
import jax
import jax.numpy as jnp
from jax import lax
import numpy as np

D_MODEL = 1024
BATCH = 1
SEQ = 16384
DEPTH = 4

GRID_W = 64
N_MEM = 256
N_EVEN = (DEPTH + 1) // 2
N_ODD = DEPTH // 2
MIX_W = D_MODEL // 2
A_HEADS = 4
A_DK = MIX_W // A_HEADS
A_DV = A_DK
CHUNK = 64
POOL_WINDOWS = (2, 4, 8, 16)
POOL_GROUPS = len(POOL_WINDOWS)
POOL_GW = MIX_W // POOL_GROUPS
C_HEADS = 4
C_KV_HEADS = 2
C_HD = MIX_W // C_HEADS
KV_W = C_KV_HEADS * C_HD
ROPE_THETA = 10000.0
Q_BLOCK = 128
CONV_W = 31
GLU_W = 2 * MIX_W
XA_HEADS = 4
XA_HD = D_MODEL // XA_HEADS
D_FF = -(-8 * D_MODEL // (3 * 256)) * 256
AB_IN = 6 * MIX_W
CD_IN = MIX_W + 2 * KV_W + GLU_W
ALPHA = (2 * DEPTH) ** 0.25
BETA = (8 * DEPTH) ** -0.25
EPS = 1e-6
F32 = jnp.float32

kernel_name = 'hybrid_hgrn2_pool_gqa_conformer_encoder'


def layer_norm(x, g, b):
    xf = x.astype(F32)
    mu = jnp.mean(xf, axis=-1, keepdims=True)
    var = jnp.mean(jnp.square(xf - mu), axis=-1, keepdims=True)
    return ((xf - mu) * lax.rsqrt(var + EPS) * g + b).astype(x.dtype)


def rms_norm(x, g):
    xf = x.astype(F32)
    return (xf * lax.rsqrt(jnp.mean(xf * xf, axis=-1, keepdims=True) + EPS) * g).astype(x.dtype)


def hgrn2_scan(q, k, v, logf):
    Bn, S, H, K = q.shape
    V = v.shape[-1]
    nc = S // CHUNK

    def chunks(a):
        return a.reshape(Bn, nc, CHUNK, H, a.shape[-1]).transpose(1, 0, 3, 2, 4)

    lower = jnp.tril(jnp.ones((CHUNK, CHUNK), bool))[:, :, None]

    def step(state, inp):
        qc, kc, vc, gc = inp
        b = jnp.cumsum(gc, axis=2)
        o_inter = jnp.einsum('bhck,bhkv->bhcv', qc * jnp.exp(b), state)
        rel = jnp.where(lower, b[:, :, :, None, :] - b[:, :, None, :, :], -jnp.inf)
        scores = jnp.einsum('bhtk,bhsk,bhtsk->bhts', qc, kc, jnp.exp(rel))
        o_intra = jnp.einsum('bhts,bhsv->bhtv', scores, vc)
        b_last = b[:, :, -1, :]
        k_dec = kc * jnp.exp(b_last[:, :, None, :] - b)
        state = jnp.exp(b_last)[..., None] * state + jnp.einsum('bhck,bhcv->bhkv', k_dec, vc)
        return state, o_inter + o_intra

    state0 = jnp.zeros((Bn, H, K, V), F32)
    _, out = lax.scan(step, state0, (chunks(q), chunks(k), chunks(v), chunks(logf)))
    return out.transpose(1, 0, 3, 2, 4).reshape(Bn, S, H, V)


def hgrn2_gates(z, lb):
    lb = lb.reshape(A_HEADS, A_DK)
    logf = jnp.logaddexp(jnp.log(lb), jnp.log1p(-lb) + jax.nn.log_sigmoid(z))
    k = (1.0 - lb) * jax.nn.sigmoid(-z)
    return k, logf


def multiscale_pool(u, pool_w, pool_scale):
    Bn, S, _ = u.shape
    uf = u.astype(F32)
    P = jnp.concatenate([jnp.zeros((Bn, 1, MIX_W), F32), jnp.cumsum(uf, axis=1)], axis=1)
    t = jnp.arange(S)
    outs = []
    for gi, w in enumerate(POOL_WINDOWS):
        lo = jnp.clip(t - w // 2, 0, S - 1)
        hi = jnp.clip(t - w // 2 + w - 1, 0, S - 1)
        sl = slice(gi * POOL_GW, (gi + 1) * POOL_GW)
        Pg = P[:, :, sl]
        cnt = (hi - lo + 1).astype(F32)[None, :, None]
        outs.append((Pg[:, hi + 1] - Pg[:, lo]) / cnt - uf[:, :, sl])
    d = jnp.stack(outs, axis=2)
    y = jnp.einsum('bsgc,gcd->bsgd', d, pool_w.astype(F32)).reshape(Bn, S, MIX_W)
    return (y * pool_scale).astype(u.dtype)


def even_mixer(x, w_in, lb_fwd, lb_bwd, norm_g, pool_w, pool_scale, w_out):
    Bn, S, _ = x.shape
    h = x @ w_in
    q, i, zf, zb, og, u = jnp.split(h, 6, axis=-1)

    def heads(a):
        return a.reshape(Bn, S, A_HEADS, A_DK).astype(F32)

    qh = heads(jax.nn.silu(q))
    vh = heads(i)
    kf, gf = hgrn2_gates(heads(zf), lb_fwd)
    kb, gb = hgrn2_gates(heads(zb), lb_bwd)
    flip = lambda a: jnp.flip(a, axis=1)
    o = hgrn2_scan(qh, kf, vh, gf) + flip(hgrn2_scan(flip(qh), flip(kb), flip(vh), flip(gb)))
    y_a = rms_norm(o, norm_g.reshape(A_HEADS, A_DV)).reshape(Bn, S, MIX_W).astype(x.dtype) * jax.nn.silu(og)
    y_b = multiscale_pool(u, pool_w, pool_scale)
    return jnp.concatenate([y_a, y_b], axis=-1) @ w_out


def axial_rope_tables(S):
    rows = S // GRID_W
    row = jnp.repeat(jnp.arange(rows), GRID_W)
    col = jnp.tile(jnp.arange(GRID_W), rows)
    half = C_HD // 2
    freqs = ROPE_THETA ** (-jnp.arange(0, half, 2, dtype=F32) / half)

    def ang(p):
        a = p.astype(F32)[:, None] * freqs[None, :]
        return jnp.concatenate([a, a], axis=-1)

    angles = jnp.concatenate([ang(row), ang(col)], axis=-1)
    return jnp.cos(angles), jnp.sin(angles)


def apply_rope(x, cos, sin):
    xs = x.reshape(x.shape[:-1] + (2, 2, C_HD // 4))
    rot = jnp.stack([-xs[..., 1, :], xs[..., 0, :]], axis=-2).reshape(x.shape)
    return (x * cos[None, :, None, :] + rot * sin[None, :, None, :]).astype(x.dtype)


def block_attention(q, k, v):
    Bn, S = q.shape[:2]
    G = C_HEADS // C_KV_HEADS
    nb = S // Q_BLOCK
    qb = q.reshape(Bn, nb, Q_BLOCK, C_KV_HEADS, G, C_HD).transpose(1, 0, 2, 3, 4, 5)
    scale = C_HD ** -0.5

    def one_block(qi):
        s = jnp.einsum('bqhgd,bkhd->bhgqk', qi, k).astype(F32) * scale
        p = jax.nn.softmax(s, axis=-1).astype(v.dtype)
        return jnp.einsum('bhgqk,bkhd->bqhgd', p, v)

    out = lax.map(one_block, qb)
    return out.transpose(1, 0, 2, 3, 4, 5).reshape(Bn, S, C_HEADS * C_HD)


def conformer_conv(a, conv_w, conv_b, ln_g, ln_b):
    val, gate = jnp.split(a, 2, axis=-1)
    u = val * jax.nn.sigmoid(gate)
    u = lax.conv_general_dilated(
        u, conv_w[:, None, :], window_strides=(1,),
        padding=[(CONV_W // 2, CONV_W // 2)],
        dimension_numbers=('NWC', 'WIO', 'NWC'),
        feature_group_count=MIX_W) + conv_b
    return jax.nn.silu(layer_norm(u, ln_g, ln_b))


def odd_mixer(x, w_in, q_g, k_g, conv_w, conv_b, ln_g, ln_b, w_out):
    Bn, S, _ = x.shape
    h = x @ w_in
    q, k, v, a = jnp.split(h, [MIX_W, MIX_W + KV_W, MIX_W + 2 * KV_W], axis=-1)
    q = rms_norm(q.reshape(Bn, S, C_HEADS, C_HD), q_g)
    k = rms_norm(k.reshape(Bn, S, C_KV_HEADS, C_HD), k_g)
    v = v.reshape(Bn, S, C_KV_HEADS, C_HD)
    cos, sin = axial_rope_tables(S)
    y_c = block_attention(apply_rope(q, cos, sin), apply_rope(k, cos, sin), v)
    y_d = conformer_conv(a, conv_w, conv_b, ln_g, ln_b)
    return jnp.concatenate([y_c, y_d], axis=-1) @ w_out


def memory_cross_attention(x, mem, wq, wkv, wo):
    Bn, S, _ = x.shape
    M = mem.shape[1]
    q = (x @ wq).reshape(Bn, S, XA_HEADS, XA_HD)
    k, v = jnp.split(mem @ wkv, 2, axis=-1)
    k = k.reshape(Bn, M, XA_HEADS, XA_HD)
    v = v.reshape(Bn, M, XA_HEADS, XA_HD)
    s = jnp.einsum('bshd,bmhd->bhsm', q, k).astype(F32) * (XA_HD ** -0.5)
    p = jax.nn.softmax(s, axis=-1).astype(x.dtype)
    o = jnp.einsum('bhsm,bmhd->bshd', p, v).reshape(Bn, S, D_MODEL)
    return o @ wo


def swiglu_ffn(x, w_gu, w_down):
    gt, up = jnp.split(x @ w_gu, 2, axis=-1)
    return (jax.nn.silu(gt) * up) @ w_down


def setup_inputs(seed: int = 0) -> dict:
    key = jax.random.key(seed)
    ks = jax.random.split(key, 24)

    def nrm(k, shape, scale):
        return jax.random.normal(k, shape, F32) * scale

    def gain(k, shape):
        return 1.0 + nrm(k, shape, 0.02)

    x = nrm(ks[0], (BATCH, SEQ, D_MODEL), 1.0)
    mem = nrm(ks[1], (BATCH, N_MEM, D_MODEL), 1.0)
    w_in_ab = nrm(ks[2], (N_EVEN, D_MODEL, AB_IN), D_MODEL ** -0.5)
    hgrn_lb_logits = nrm(ks[3], (2, DEPTH, MIX_W), 0.5)
    hgrn_norm_g = gain(ks[4], (N_EVEN, MIX_W))
    pool_w = nrm(ks[5], (N_EVEN, POOL_GROUPS, POOL_GW, POOL_GW), POOL_GW ** -0.5)
    pool_scale = gain(ks[6], (N_EVEN, MIX_W))
    w_out_ab = nrm(ks[7], (N_EVEN, 2 * MIX_W, D_MODEL), BETA * (2 * MIX_W) ** -0.5)
    w_in_cd = nrm(ks[8], (N_ODD, D_MODEL, CD_IN), D_MODEL ** -0.5)
    q_norm_g = gain(ks[9], (N_ODD, C_HD))
    k_norm_g = gain(ks[10], (N_ODD, C_HD))
    conv_w = nrm(ks[11], (N_ODD, CONV_W, MIX_W), CONV_W ** -0.5)
    conv_b = nrm(ks[12], (N_ODD, MIX_W), 0.02)
    conv_ln_g = gain(ks[13], (N_ODD, MIX_W))
    conv_ln_b = nrm(ks[14], (N_ODD, MIX_W), 0.02)
    w_out_cd = nrm(ks[15], (N_ODD, 2 * MIX_W, D_MODEL), BETA * (2 * MIX_W) ** -0.5)
    xa_wq = nrm(ks[16], (DEPTH, D_MODEL, D_MODEL), D_MODEL ** -0.5)
    xa_wkv = jnp.concatenate([
        nrm(ks[17], (DEPTH, D_MODEL, D_MODEL), D_MODEL ** -0.5),
        nrm(ks[18], (DEPTH, D_MODEL, D_MODEL), BETA * D_MODEL ** -0.5)], axis=-1)
    xa_wo = nrm(ks[19], (DEPTH, D_MODEL, D_MODEL), BETA * D_MODEL ** -0.5)
    ffn_w_gu = nrm(ks[20], (DEPTH, D_MODEL, 2 * D_FF), BETA * D_MODEL ** -0.5)
    ffn_w_down = nrm(ks[21], (DEPTH, D_FF, D_MODEL), BETA * D_FF ** -0.5)
    ln_g = gain(ks[22], (DEPTH, 3, D_MODEL))
    ln_b = nrm(ks[23], (DEPTH, 3, D_MODEL), 0.02)
    return {'x': x, 'mem': mem, 'w_in_ab': w_in_ab, 'hgrn_lb_logits': hgrn_lb_logits,
            'hgrn_norm_g': hgrn_norm_g, 'pool_w': pool_w, 'pool_scale': pool_scale,
            'w_out_ab': w_out_ab, 'w_in_cd': w_in_cd, 'q_norm_g': q_norm_g,
            'k_norm_g': k_norm_g, 'conv_w': conv_w, 'conv_b': conv_b,
            'conv_ln_g': conv_ln_g, 'conv_ln_b': conv_ln_b, 'w_out_cd': w_out_cd,
            'xa_wq': xa_wq, 'xa_wkv': xa_wkv, 'xa_wo': xa_wo, 'ffn_w_gu': ffn_w_gu,
            'ffn_w_down': ffn_w_down, 'ln_g': ln_g, 'ln_b': ln_b}


def reference(x, mem, w_in_ab, hgrn_lb_logits, hgrn_norm_g, pool_w, pool_scale, w_out_ab,
              w_in_cd, q_norm_g, k_norm_g, conv_w, conv_b, conv_ln_g, conv_ln_b, w_out_cd,
              xa_wq, xa_wkv, xa_wo, ffn_w_gu, ffn_w_down, ln_g, ln_b):
    cum = jnp.cumsum(jax.nn.softmax(hgrn_lb_logits.astype(F32), axis=1), axis=1)
    lb = jnp.maximum(cum - cum[:, :1], 0.0)
    for l in range(DEPTH):
        j = l // 2
        if l % 2 == 0:
            y = even_mixer(x, w_in_ab[j], lb[0, l], lb[1, l], hgrn_norm_g[j],
                           pool_w[j], pool_scale[j], w_out_ab[j])
        else:
            y = odd_mixer(x, w_in_cd[j], q_norm_g[j], k_norm_g[j], conv_w[j], conv_b[j],
                          conv_ln_g[j], conv_ln_b[j], w_out_cd[j])
        x = layer_norm(ALPHA * x + y, ln_g[l, 0], ln_b[l, 0])
        x = layer_norm(ALPHA * x + memory_cross_attention(x, mem, xa_wq[l], xa_wkv[l], xa_wo[l]),
                       ln_g[l, 1], ln_b[l, 1])
        x = layer_norm(ALPHA * x + swiglu_ffn(x, ffn_w_gu[l], ffn_w_down[l]),
                       ln_g[l, 2], ln_b[l, 2])
    return x
```

```cpp
#include <hip/hip_runtime.h>
#include <hip/hip_cooperative_groups.h>
#include <cstdio>
#include <cstdint>
namespace cg = cooperative_groups;
__device__ __forceinline__ int otid() { int t = threadIdx.x; asm volatile("" : "+v"(t)); return t; }
namespace pg8 {
#define PG8_LAS __attribute__((address_space(3)))
typedef unsigned short bf16_t;
typedef short bf16x8 __attribute__((ext_vector_type(8)));
typedef float f32x4 __attribute__((ext_vector_type(4)));
typedef unsigned u32x4 __attribute__((ext_vector_type(4)));
constexpr int BM = 256, BK = 64, HALF = 128, HTB = HALF * BK * 2  , STAGE_BYTES = 8 * HTB, NXCD = 8, WGM = 8;

__host__ __device__ __forceinline__ int lds_byte(int r, int c) { const int st = (r >> 4) * 2 + (c >> 5), rr = r & 15, cc = c & 31, ob = rr * 64 + cc * 2; return st * 1024 + (ob ^ (((ob >> 9) & 1) << 5)); }
__host__ __device__ __forceinline__ void stage_rc(int b, int& R, int& C) { const int st = b / 1024, sb = b % 1024, swz = sb ^ (((sb >> 9) & 1) << 5); R = (st >> 1) * 16 + swz / 64; C = (st & 1) * 32 + (swz % 64) / 2; }
__host__ __device__ __forceinline__ int perm32(int rho) { const int n = rho >> 4, i = rho & 15; return 8 * (i >> 2) + 4 * n + (i & 3); }

struct Unit { int pm, pn; };
struct Gemm { const bf16_t* A; const bf16_t* Bt; int M, N, K, lda, ldb; long a_pn, b_pn; };

struct StaticOrder {
    int nM, nN, nwg, G, c;
    __host__ __device__ void init(int M, int N, int G_, int c_) { nM = M / BM; nN = N / BM; nwg = nM * nN; G = G_; c = c_; }
    __host__ __device__ bool next(int i, Unit& u) const {
        const long L = (long)i * G + c; if (L >= nwg) return false;
        int wgid = (int)L; { const int q = nwg / NXCD, r = nwg % NXCD, xcd = wgid % NXCD, off = wgid / NXCD; wgid = (xcd < r ? xcd * (q + 1) : r * (q + 1) + (xcd - r) * q) + off; }
        const int nig = WGM * nN, gid = wgid / nig, fm = gid * WGM, gsz = (nM - fm) < WGM ? (nM - fm) : WGM;
        u.pm = fm + ((wgid % nig) % gsz); u.pn = (wgid % nig) / gsz; return true;
    }
    __device__ __forceinline__ void a_ready(const Unit&) const {}
    __device__ __forceinline__ void done(const Unit&) const {}
};


template <class Epi, class Sched, bool ALIGN_EPI = false, bool SP2 = false>
__device__ __forceinline__ void gemm_phase(PG8_LAS unsigned char* lds, const Gemm g, const Sched& S, const Epi& E) {
    const int tid = otid(), wid = __builtin_amdgcn_readfirstlane(tid >> 6), lane = tid & 63, wr = wid >> 2, wc = wid & 3, fr = lane & 15, fq = lane >> 4;
    const int K = g.K, nt = K / BK;
    unsigned voffA[2], voffB[2];
#pragma unroll
    for (int i = 0; i < 2; ++i) { int R, C; stage_rc(tid * 16 + i * 8192, R, C); const int Rb = Epi::PERM ? ((R & ~31) + perm32(R & 31)) : R;
        voffA[i] = (unsigned)(R * g.lda + C) * 2u; voffB[i] = (unsigned)(Rb * g.ldb + C) * 2u; }
    const size_t kstep = (size_t)(BK * 2);
    const size_t hA = (size_t)HALF * g.lda * 2, hB = (size_t)HALF * g.ldb * 2;
    const unsigned ldsw = (unsigned)wid * 1024u;
    const int aoff = lds_byte(wr * 64 + fr, fq * 8), boff = lds_byte(wc * 32 + fr, fq * 8);
#define PG8_AOF(u) ((const char*)g.A + ((size_t)(u).pm * 256 * g.lda + (size_t)(u).pn * g.a_pn) * 2)
#define PG8_BOF(u) ((const char*)g.Bt + (size_t)(u).pn * g.b_pn * 2)
#define PG8_SA(b, h) (((b) * 2 + (h)) * HTB)
#define PG8_SB(b, h) ((4 + (b) * 2 + (h)) * HTB)
#define PG8_STAGE(bufoff, gbase, voff) do { _Pragma("unroll") for (int _i = 0; _i < 2; ++_i) \
        __builtin_amdgcn_global_load_lds((const unsigned*)((const char*)(gbase) + (voff)[_i]), (PG8_LAS unsigned*)(lds + (bufoff) + ldsw + _i * 8192), 16, 0, 0); } while (0)
#define PG8_LDA(dst, b, h) do { _Pragma("unroll") for (int m = 0; m < 4; ++m) _Pragma("unroll") for (int k = 0; k < 2; ++k) dst[m][k] = *(const PG8_LAS bf16x8*)(lds + PG8_SA(b, h) + aoff + m * 2048 + k * 1024); } while (0)
#define PG8_LDB(dst, b, h) do { _Pragma("unroll") for (int n = 0; n < 2; ++n) _Pragma("unroll") for (int k = 0; k < 2; ++k) dst[n][k] = *(const PG8_LAS bf16x8*)(lds + PG8_SB(b, h) + boff + n * 2048 + k * 1024); } while (0)
#define PG8_MMA(ai, bj, At, Bt) do { __builtin_amdgcn_s_setprio(1); _Pragma("unroll") for (int m = 0; m < 4; ++m) _Pragma("unroll") for (int n = 0; n < 2; ++n) _Pragma("unroll") for (int k = 0; k < 2; ++k) \
        acc[ai][bj][m][n] = __builtin_amdgcn_mfma_f32_16x16x32_bf16(Bt[n][k], At[m][k], acc[ai][bj][m][n], 0, 0, 0); __builtin_amdgcn_s_setprio(0); } while (0)
#define PG8_WAIT_V(n) asm volatile("s_waitcnt vmcnt(" #n ")" ::: "memory")
#define PG8_WAIT_L(n) asm volatile("s_waitcnt lgkmcnt(" #n ")" ::: "memory")
#define PG8_BAR __builtin_amdgcn_s_barrier()
#define PG8_SCHED __builtin_amdgcn_sched_barrier(0)
    Unit cur, nxt; int ui = 0;
    if (!S.next(0, cur)) return;
    f32x4 acc[2][2][4][2];
#pragma unroll
    for (int a = 0; a < 2; ++a)
#pragma unroll
        for (int b = 0; b < 2; ++b)
#pragma unroll
            for (int m = 0; m < 4; ++m)
#pragma unroll
                for (int n = 0; n < 2; ++n) acc[a][b][m][n] = (f32x4){0.f, 0.f, 0.f, 0.f};
    bf16x8 At[4][2], B0[2][2], B1[2][2];
    const char* cA = PG8_AOF(cur); const char* cB = PG8_BOF(cur);
    S.a_ready(cur);
    if constexpr (SP2) {
        PG8_STAGE(PG8_SB(0, 0), cB, voffB); PG8_STAGE(PG8_SB(0, 1), cB + hB, voffB); PG8_STAGE(PG8_SA(0, 0), cA, voffA); PG8_STAGE(PG8_SA(0, 1), cA + hA, voffA);
        if (wr == 1) PG8_BAR;
        PG8_WAIT_V(2); PG8_BAR;
        PG8_STAGE(PG8_SB(1, 0), cB + kstep, voffB); PG8_STAGE(PG8_SA(1, 0), cA + kstep, voffA); PG8_STAGE(PG8_SB(1, 1), cB + hB + kstep, voffB);
        PG8_WAIT_V(6); PG8_BAR;
    } else {
        PG8_STAGE(PG8_SB(0, 0), cB, voffB); PG8_STAGE(PG8_SA(0, 0), cA, voffA); PG8_STAGE(PG8_SB(0, 1), cB + hB, voffB); PG8_STAGE(PG8_SA(0, 1), cA + hA, voffA);
        if (wr == 1) PG8_BAR;
        PG8_WAIT_V(4); PG8_BAR;
        PG8_STAGE(PG8_SB(1, 0), cB + kstep, voffB); PG8_STAGE(PG8_SA(1, 0), cA + kstep, voffA); PG8_STAGE(PG8_SB(1, 1), cB + hB + kstep, voffB);
        PG8_WAIT_V(6); PG8_BAR;
    }
    for (;;) {
        const bool has_next = S.next(ui + 1, nxt);
        const char* nA = has_next ? PG8_AOF(nxt) : cA; const char* nB = has_next ? PG8_BOF(nxt) : cB;
        for (int t = 0; t < nt; t += 2) {
            const bool last = (t == nt - 2);
            const char* a1 = cA + (size_t)(t + 1) * kstep;
            const char* a2 = last ? nA : cA + (size_t)(t + 2) * kstep; const char* b2 = last ? nB : cB + (size_t)(t + 2) * kstep;
            const char* a3 = a2 + kstep; const char* b3 = b2 + kstep;
            if (last && has_next) S.a_ready(nxt);
            if constexpr (SP2) {
            PG8_LDB(B0, 0, 0); PG8_LDB(B1, 0, 1); PG8_SCHED; PG8_LDA(At, 0, 0); PG8_STAGE(PG8_SA(1, 1), a1 + hA, voffA);
            PG8_WAIT_V(8); PG8_WAIT_L(0); PG8_BAR; PG8_MMA(0, 0, At, B0); PG8_MMA(0, 1, At, B1); PG8_BAR; PG8_SCHED;
            PG8_LDA(At, 0, 1); PG8_STAGE(PG8_SB(0, 0), b2, voffB); PG8_STAGE(PG8_SB(0, 1), b2 + hB, voffB); PG8_STAGE(PG8_SA(0, 0), a2, voffA);
            PG8_WAIT_V(8); PG8_WAIT_L(0); PG8_BAR; PG8_MMA(1, 0, At, B0); PG8_MMA(1, 1, At, B1); PG8_BAR; PG8_SCHED;
            PG8_LDB(B0, 1, 0); PG8_LDB(B1, 1, 1); PG8_SCHED; PG8_LDA(At, 1, 0); PG8_STAGE(PG8_SA(0, 1), a2 + hA, voffA);
            PG8_WAIT_V(8); PG8_WAIT_L(0); PG8_BAR; PG8_MMA(0, 0, At, B0); PG8_MMA(0, 1, At, B1); PG8_BAR; PG8_SCHED;
            PG8_LDA(At, 1, 1); PG8_STAGE(PG8_SB(1, 0), b3, voffB); PG8_STAGE(PG8_SB(1, 1), b3 + hB, voffB); PG8_STAGE(PG8_SA(1, 0), a3, voffA);
            PG8_WAIT_V(8); PG8_WAIT_L(0); PG8_BAR; PG8_MMA(1, 0, At, B0); PG8_MMA(1, 1, At, B1); PG8_BAR; PG8_SCHED;
            } else {
            PG8_LDB(B0, 0, 0); PG8_SCHED; PG8_LDA(At, 0, 0); PG8_STAGE(PG8_SA(1, 1), a1 + hA, voffA);
            PG8_WAIT_L(8); PG8_BAR; PG8_WAIT_L(0); PG8_MMA(0, 0, At, B0); PG8_BAR; PG8_SCHED;
            PG8_LDB(B1, 0, 1); PG8_STAGE(PG8_SB(0, 0), b2, voffB);
            PG8_BAR; PG8_WAIT_L(0); PG8_MMA(0, 1, At, B1); PG8_BAR;
            PG8_LDA(At, 0, 1); PG8_STAGE(PG8_SA(0, 0), a2, voffA);
            PG8_BAR; PG8_WAIT_L(0); PG8_MMA(1, 0, At, B0); PG8_BAR; PG8_SCHED;
            PG8_STAGE(PG8_SB(0, 1), b2 + hB, voffB);
            PG8_WAIT_V(6); PG8_BAR; PG8_MMA(1, 1, At, B1); PG8_BAR;
            PG8_LDB(B0, 1, 0); PG8_SCHED; PG8_LDA(At, 1, 0); PG8_STAGE(PG8_SA(0, 1), a2 + hA, voffA);
            PG8_WAIT_L(8); PG8_BAR; PG8_WAIT_L(0); PG8_MMA(0, 0, At, B0); PG8_BAR; PG8_SCHED;
            PG8_LDB(B1, 1, 1); PG8_STAGE(PG8_SB(1, 0), b3, voffB);
            PG8_BAR; PG8_WAIT_L(0); PG8_MMA(0, 1, At, B1); PG8_BAR;
            PG8_LDA(At, 1, 1); PG8_STAGE(PG8_SA(1, 0), a3, voffA);
            PG8_BAR; PG8_WAIT_L(0); PG8_MMA(1, 0, At, B0); PG8_BAR; PG8_SCHED;
            PG8_STAGE(PG8_SB(1, 1), b3 + hB, voffB);
            PG8_WAIT_V(6); PG8_BAR; PG8_MMA(1, 1, At, B1); PG8_BAR;
            }
        }
        if constexpr (ALIGN_EPI) { if (wr == 0) PG8_BAR; }
        if constexpr (!Epi::AFTER_DRAIN) { E(acc, cur, wr, wc, fr, fq); S.done(cur); }
        if (!has_next) break;
#pragma unroll
        for (int a = 0; a < 2; ++a)
#pragma unroll
            for (int b = 0; b < 2; ++b)
#pragma unroll
                for (int m = 0; m < 4; ++m)
#pragma unroll
                    for (int n = 0; n < 2; ++n) acc[a][b][m][n] = (f32x4){0.f, 0.f, 0.f, 0.f};
        cur = nxt; cA = nA; cB = nB; ++ui;
        if constexpr (ALIGN_EPI) { if (wr == 1) PG8_BAR; }
    }
    PG8_WAIT_V(0);
    if constexpr (!ALIGN_EPI) { if (wr == 0) PG8_BAR; }
    PG8_BAR;
    if constexpr (Epi::AFTER_DRAIN) { E.fused(acc, cur, wr, wc, fr, fq, lds, wid, lane); S.done(cur); }
#undef PG8_SA
#undef PG8_AOF
#undef PG8_BOF
#undef PG8_SB
#undef PG8_STAGE
#undef PG8_LDA
#undef PG8_LDB
#undef PG8_MMA
#undef PG8_WAIT_V
#undef PG8_WAIT_L
#undef PG8_BAR
#undef PG8_SCHED
}
}
namespace pg8 {
typedef unsigned u32x2 __attribute__((ext_vector_type(2)));
__device__ __forceinline__ unsigned cvt_pk_bf16(float lo, float hi) { unsigned r; asm volatile("v_cvt_pk_bf16_f32 %0, %1, %2" : "=v"(r) : "v"(lo), "v"(hi)); return r; }
__device__ __forceinline__ float siluf(float x) { return x * __builtin_amdgcn_rcpf(1.f + __expf(-x)); }
struct EpiStore {
    static constexpr bool PERM = true, AFTER_DRAIN = false;
    bf16_t* O; int ldc; int silu_cols; float scale;
    __device__ __forceinline__ void operator()(const f32x4 (&acc)[2][2][4][2], const Unit& u, int wr, int wc, int fr, int fq) const {
        const int row0 = u.pm * BM + wr * 64 + fr, col0 = u.pn * BM + wc * 32 + 8 * fq;
        const bool act = (u.pn * BM) < silu_cols;
#pragma unroll
        for (int ai = 0; ai < 2; ++ai)
#pragma unroll
            for (int m = 0; m < 4; ++m) { bf16_t* rowp = O + (size_t)(row0 + ai * HALF + m * 16) * ldc + col0;
#pragma unroll
                for (int bj = 0; bj < 2; ++bj) { f32x4 v0 = acc[ai][bj][m][0], v1 = acc[ai][bj][m][1];
                    if (act) {
#pragma unroll
                        for (int e = 0; e < 4; ++e) { v0[e] = siluf(v0[e]); v1[e] = siluf(v1[e]); } }
                    v0 = v0 * scale; v1 = v1 * scale; u32x4 w; w.x = cvt_pk_bf16(v0[0], v0[1]); w.y = cvt_pk_bf16(v0[2], v0[3]); w.z = cvt_pk_bf16(v1[0], v1[1]); w.w = cvt_pk_bf16(v1[2], v1[3]);
                    *(u32x4*)(rowp + bj * HALF) = w; } }
    }
};
struct EpiSwiGLU {
    static constexpr bool PERM = true, AFTER_DRAIN = false;
    bf16_t* O; int ldc;
    __device__ __forceinline__ void operator()(const f32x4 (&acc)[2][2][4][2], const Unit& u, int wr, int wc, int fr, int fq) const {
        const int row0 = u.pm * BM + wr * 64 + fr, col0 = u.pn * HALF + wc * 32 + 8 * fq;
#pragma unroll
        for (int ai = 0; ai < 2; ++ai)
#pragma unroll
            for (int m = 0; m < 4; ++m) { bf16_t* rowp = O + (size_t)(row0 + ai * HALF + m * 16) * ldc + col0;
                f32x4 h0, h1;
#pragma unroll
                for (int e = 0; e < 4; ++e) { h0[e] = siluf(acc[ai][0][m][0][e]) * acc[ai][1][m][0][e]; h1[e] = siluf(acc[ai][0][m][1][e]) * acc[ai][1][m][1][e]; }
                u32x4 w; w.x = cvt_pk_bf16(h0[0], h0[1]); w.y = cvt_pk_bf16(h0[2], h0[3]); w.z = cvt_pk_bf16(h1[0], h1[1]); w.w = cvt_pk_bf16(h1[2], h1[3]);
                *(u32x4*)rowp = w; }
    }
};
struct EpiResid {
    static constexpr bool PERM = false, AFTER_DRAIN = false;
    const float* xin; float* z; float alpha;
    __device__ __forceinline__ void operator()(const f32x4 (&acc)[2][2][4][2], const Unit& u, int wr, int wc, int fr, int fq) const {
        const int col0 = u.pn * BM + wc * 32 + 4 * fq;
#pragma unroll
        for (int ai = 0; ai < 2; ++ai)
#pragma unroll
            for (int m = 0; m < 4; ++m) { const size_t off = (size_t)(u.pm * BM + ai * HALF + wr * 64 + m * 16 + fr) * 1024 + col0;
#pragma unroll
                for (int bj = 0; bj < 2; ++bj)
#pragma unroll
                    for (int n = 0; n < 2; ++n) { const f32x4 xv = *(const f32x4*)(xin + off + bj * HALF + n * 16); *(f32x4*)(z + off + bj * HALF + n * 16) = xv * alpha + acc[ai][bj][m][n]; } }
    }
};
struct EpiSoftmax {
    static constexpr bool PERM = false, AFTER_DRAIN = true;
    bf16_t* P;
    __device__ __forceinline__ void fused(f32x4 (&acc)[2][2][4][2], const Unit& u, int wr, int wc, int fr, int fq, PG8_LAS unsigned char* lds, int wid, int lane) const {
        typedef float f32x2v __attribute__((ext_vector_type(2)));
        PG8_LAS f32x2v* X = (PG8_LAS f32x2v*)lds;
        float mxl[2][4];
#pragma unroll
        for (int ai = 0; ai < 2; ++ai)
#pragma unroll
            for (int m = 0; m < 4; ++m) {
                float mx = -3.0e38f;
#pragma unroll
                for (int bj = 0; bj < 2; ++bj)
#pragma unroll
                    for (int n = 0; n < 2; ++n) { const f32x4 x = acc[ai][bj][m][n]; mx = fmaxf(mx, fmaxf(fmaxf(x[0], x[1]), fmaxf(x[2], x[3]))); }
                mx = fmaxf(mx, __shfl_xor(mx, 16)); mx = fmaxf(mx, __shfl_xor(mx, 32));
                float s = 0.f;
#pragma unroll
                for (int bj = 0; bj < 2; ++bj)
#pragma unroll
                    for (int n = 0; n < 2; ++n) { f32x4 x = acc[ai][bj][m][n];
#pragma unroll
                        for (int e = 0; e < 4; ++e) { x[e] = __builtin_amdgcn_exp2f(x[e] - mx); s += x[e]; }
                        acc[ai][bj][m][n] = x; }
                s += __shfl_xor(s, 16); s += __shfl_xor(s, 32);
                mxl[ai][m] = mx;
                if (fq == 0) X[(ai * HALF + wr * 64 + m * 16 + fr) * 4 + wc] = (f32x2v){mx, s};
            }
        asm volatile("s_waitcnt lgkmcnt(0)" ::: "memory"); __builtin_amdgcn_s_barrier(); asm volatile("" ::: "memory");
        const int col0 = u.pn * BM + wc * 32 + 4 * fq;
#pragma unroll
        for (int ai = 0; ai < 2; ++ai)
#pragma unroll
            for (int m = 0; m < 4; ++m) { const int r = ai * HALF + wr * 64 + m * 16 + fr;
                const f32x2v a = X[r * 4 + 0], b = X[r * 4 + 1], c = X[r * 4 + 2], d = X[r * 4 + 3];
                const float gm = fmaxf(fmaxf(a.x, b.x), fmaxf(c.x, d.x));
                const float S = a.y * __builtin_amdgcn_exp2f(a.x - gm) + b.y * __builtin_amdgcn_exp2f(b.x - gm) + c.y * __builtin_amdgcn_exp2f(c.x - gm) + d.y * __builtin_amdgcn_exp2f(d.x - gm);
                const float f = __builtin_amdgcn_exp2f(mxl[ai][m] - gm) / S;
                bf16_t* rowp = P + (size_t)(u.pm * BM + r) * 1024 + col0;
#pragma unroll
                for (int bj = 0; bj < 2; ++bj)
#pragma unroll
                    for (int n = 0; n < 2; ++n) { const f32x4 x = acc[ai][bj][m][n] * f; u32x2 w; w.x = cvt_pk_bf16(x[0], x[1]); w.y = cvt_pk_bf16(x[2], x[3]); *(u32x2*)(rowp + bj * HALF + n * 16) = w; } }
        asm volatile("s_waitcnt lgkmcnt(0)" ::: "memory"); __builtin_amdgcn_s_barrier(); asm volatile("" ::: "memory");
    }
};
}
#define LAS __attribute__((address_space(3)))
typedef unsigned short bf16_t;
typedef short bf16x8 __attribute__((ext_vector_type(8)));
typedef short s16x4 __attribute__((ext_vector_type(4)));
typedef float f32x2 __attribute__((ext_vector_type(2)));
typedef float f32x4 __attribute__((ext_vector_type(4)));
typedef float f32x16 __attribute__((ext_vector_type(16)));
typedef unsigned u32x2 __attribute__((ext_vector_type(2)));
typedef unsigned u32x4 __attribute__((ext_vector_type(4)));
constexpr int M = 16384, DM = 1024, NMEM = 256, DFF = 2816;
constexpr float ALPHA = 1.6817928305074290f, LN_EPS = 1e-6f;
constexpr int LDS_BYTES = 147456;
constexpr size_t MiB = 1u << 20;
constexpr size_t O_CTL = 0;
constexpr size_t O_WAB = 1 * MiB;
constexpr size_t O_WOAB = O_WAB + 2ull * 3072 * 1024 * 2;
constexpr size_t O_WCD = O_WOAB + 2ull * 1024 * 1024 * 2;
constexpr size_t O_WOCD = O_WCD + 2ull * 2048 * 1024 * 2;
constexpr size_t O_WQ = O_WOCD + 2ull * 1024 * 1024 * 2;
constexpr size_t O_WKV = O_WQ + 4ull * 1024 * 1024 * 2;
constexpr size_t O_WO = O_WKV + 4ull * 2048 * 1024 * 2;
constexpr size_t O_WGU = O_WO + 4ull * 1024 * 1024 * 2;
constexpr size_t O_WDN = O_WGU + 4ull * 5632 * 1024 * 2;
constexpr size_t O_MEMB = O_WDN + 4ull * 1024 * 2816 * 2;
constexpr size_t O_XK = O_MEMB + 256ull * 1024 * 2;
constexpr size_t O_XVT = O_XK + 4ull * 256 * 1024 * 2;
constexpr size_t O_H = O_XVT + 4ull * 1024 * 256 * 2;
constexpr size_t O_CAT = O_H + (size_t)M * 3072 * 2;
constexpr size_t O_XN = O_CAT + (size_t)M * 1024 * 2;
constexpr size_t O_OF = O_XN + (size_t)M * 1024 * 2;
constexpr size_t O_ST = O_OF + (size_t)M * 512 * 4;
constexpr size_t O_END = O_ST + 8ull * 32 * 16384 * 4;

__device__ __forceinline__ float bf2f(unsigned h) { return __uint_as_float(h << 16); }
__device__ __forceinline__ unsigned pk2(float lo, float hi) { return pg8::cvt_pk_bf16(lo, hi); }
__device__ __forceinline__ float wave_sum(float v) {
#pragma unroll
    for (int o = 1; o < 64; o <<= 1) v += __shfl_xor(v, o);
    return v;
}
#define LDS_WAIT() asm volatile("s_waitcnt lgkmcnt(0)" ::: "memory")

__device__ __forceinline__ void tr_item(const float* W, int N, bf16_t* WT, int ldo, int orow0, LAS float* scr, int k0, int n0, int lane) {
#pragma unroll 8
    for (int i = 0; i < 32; ++i) { const int kk = 2 * i + (lane >> 5); scr[kk * 33 + (lane & 31)] = W[(size_t)(k0 + kk) * N + n0 + (lane & 31)]; }
    LDS_WAIT(); asm volatile("" ::: "memory");
    const int c = lane & 7;
#pragma unroll
    for (int j = 0; j < 4; ++j) { const int n = (lane >> 3) + 8 * j; const LAS float* s = scr + (8 * c) * 33 + n;
        u32x4 o; o.x = pk2(s[0 * 33], s[1 * 33]); o.y = pk2(s[2 * 33], s[3 * 33]); o.z = pk2(s[4 * 33], s[5 * 33]); o.w = pk2(s[6 * 33], s[7 * 33]);
        *(u32x4*)(WT + (size_t)(orow0 + n) * ldo + k0 + 8 * c) = o; }
    LDS_WAIT(); asm volatile("" ::: "memory");
}
struct Args { const float* in[23]; float* out; unsigned char* ws; };

__device__ __forceinline__ void prologue(const Args& a, LAS unsigned char* lds, int G) {
    const int tid = otid(), lane = tid & 63, wave = __builtin_amdgcn_readfirstlane(tid >> 6);
    LAS float* scr = (LAS float*)(lds + wave * 16384);
    const int gw = blockIdx.x * 8 + wave, NGW = G * 8;
    unsigned char* ws = a.ws;
    constexpr int I_AB = 16 * 96, I_OAB = 8 * 32, I_CD = 16 * 64, I_OCD = 16 * 32, I_Q = 16 * 32, I_KV = 16 * 64, I_O = 16 * 32, I_GU = 16 * 176, I_DN = 44 * 32;
    constexpr int NITEMS = 2 * I_AB + 2 * I_OAB + 2 * I_CD + 2 * I_OCD + 4 * I_Q + 4 * I_KV + 4 * I_O + 4 * I_GU + 4 * I_DN;
    for (int it = gw; it < NITEMS; it += NGW) {
        int r = it;
        if (r < 2 * I_AB) { const int j = r / I_AB, q = r % I_AB, kb = q / 96, nb = q % 96;
            tr_item(a.in[2] + (size_t)j * 1024 * 3072, 3072, (bf16_t*)(ws + O_WAB) + (size_t)j * 3072 * 1024, 1024, 32 * nb, scr, 64 * kb, 32 * nb, lane); continue; } r -= 2 * I_AB;
        if (r < 2 * I_OAB) { const int j = r / I_OAB, q = r % I_OAB, kb = q / 32, nb = q % 32;
            tr_item(a.in[7] + (size_t)j * 1024 * 1024, 1024, (bf16_t*)(ws + O_WOAB) + (size_t)j * 1024 * 1024, 1024, 32 * nb, scr, 64 * kb, 32 * nb, lane); continue; } r -= 2 * I_OAB;
        if (r < 2 * I_CD) { const int j = r / I_CD, q = r % I_CD, kb = q / 64, nb = q % 64;
            tr_item(a.in[8] + (size_t)j * 1024 * 2048, 2048, (bf16_t*)(ws + O_WCD) + (size_t)j * 2048 * 1024, 1024, 32 * nb, scr, 64 * kb, 32 * nb, lane); continue; } r -= 2 * I_CD;
        if (r < 2 * I_OCD) { const int j = r / I_OCD, q = r % I_OCD, kb = q / 32, nb = q % 32;
            tr_item(a.in[15] + (size_t)j * 1024 * 1024, 1024, (bf16_t*)(ws + O_WOCD) + (size_t)j * 1024 * 1024, 1024, 32 * nb, scr, 64 * kb, 32 * nb, lane); continue; } r -= 2 * I_OCD;
        if (r < 4 * I_Q) { const int j = r / I_Q, q = r % I_Q, kb = q / 32, nb = q % 32;
            tr_item(a.in[16] + (size_t)j * 1024 * 1024, 1024, (bf16_t*)(ws + O_WQ) + (size_t)j * 1024 * 1024, 1024, 32 * nb, scr, 64 * kb, 32 * nb, lane); continue; } r -= 4 * I_Q;
        if (r < 4 * I_KV) { const int j = r / I_KV, q = r % I_KV, kb = q / 64, nb = q % 64;
            tr_item(a.in[17] + (size_t)j * 1024 * 2048, 2048, (bf16_t*)(ws + O_WKV) + (size_t)j * 2048 * 1024, 1024, 32 * nb, scr, 64 * kb, 32 * nb, lane); continue; } r -= 4 * I_KV;
        if (r < 4 * I_O) { const int j = r / I_O, q = r % I_O, kb = q / 32, nb = q % 32;
            tr_item(a.in[18] + (size_t)j * 1024 * 1024, 1024, (bf16_t*)(ws + O_WO) + (size_t)j * 1024 * 1024, 1024, 32 * nb, scr, 64 * kb, 32 * nb, lane); continue; } r -= 4 * I_O;
        if (r < 4 * I_GU) { const int j = r / I_GU, q = r % I_GU, kb = q / 176, nb = q % 176; const int n0 = 32 * nb;
            const int orow0 = n0 < DFF ? (n0 / 128) * 256 + (n0 % 128) : ((n0 - DFF) / 128) * 256 + 128 + ((n0 - DFF) % 128);
            tr_item(a.in[19] + (size_t)j * 1024 * 5632, 5632, (bf16_t*)(ws + O_WGU) + (size_t)j * 5632 * 1024, 1024, orow0, scr, 64 * kb, n0, lane); continue; } r -= 4 * I_GU;
        { const int j = r / I_DN, q = r % I_DN, kb = q / 32, nb = q % 32;
            tr_item(a.in[20] + (size_t)j * 2816 * 1024, 1024, (bf16_t*)(ws + O_WDN) + (size_t)j * 1024 * 2816, 2816, 32 * nb, scr, 64 * kb, 32 * nb, lane); }
    }
    for (int it = gw; it < 2048; it += NGW) {
        const int db = it & 15, cgp = (it >> 4) & 15, g = (it >> 8) & 3, j = it >> 10, n = db * 64 + lane, c0 = cgp * 8;
        const float* wo = a.in[7] + (size_t)j * 1024 * 1024 + (size_t)(512 + g * 128) * 1024 + n;
        const float* ps = a.in[6] + j * 512 + g * 128;
        const float* pw = a.in[5] + ((size_t)(j * 4 + g) * 128 + c0) * 128;
        float acc[8];
#pragma unroll
        for (int ci = 0; ci < 8; ++ci) acc[ci] = 0.f;
        for (int e = 0; e < 128; ++e) { const float w = wo[(size_t)e * 1024] * ps[e];
#pragma unroll
            for (int ci = 0; ci < 8; ++ci) acc[ci] += pw[ci * 128 + e] * w; }
        u32x4 o; o.x = pk2(acc[0], acc[1]); o.y = pk2(acc[2], acc[3]); o.z = pk2(acc[4], acc[5]); o.w = pk2(acc[6], acc[7]);
        *(u32x4*)((bf16_t*)(ws + O_WOAB) + (size_t)j * 1024 * 1024 + (size_t)n * 1024 + 512 + g * 128 + c0) = o;
    }
    const int gt = blockIdx.x * 512 + tid, GT = G * 512;
    for (int i = gt; i < NMEM * DM / 8; i += GT) { const f32x4 p = ((const f32x4*)a.in[1])[2 * i], q = ((const f32x4*)a.in[1])[2 * i + 1];
        u32x4 o; o.x = pk2(p[0], p[1]); o.y = pk2(p[2], p[3]); o.z = pk2(q[0], q[1]); o.w = pk2(q[2], q[3]); ((u32x4*)(ws + O_MEMB))[i] = o; }
    for (int i = gt; i < M * DM / 8; i += GT) { const f32x4 p = ((const f32x4*)a.in[0])[2 * i], q = ((const f32x4*)a.in[0])[2 * i + 1];
        u32x4 o; o.x = pk2(p[0], p[1]); o.y = pk2(p[2], p[3]); o.z = pk2(q[0], q[1]); o.w = pk2(q[2], q[3]); ((u32x4*)(ws + O_XN))[i] = o; }
    if (blockIdx.x == 0) {
        for (int i = tid; i < 1024; i += 512) { const int dir = i >> 9, c = i & 511; const float* lg = a.in[3] + (size_t)dir * 4 * 512 + c;
            const float l0 = lg[0], l1 = lg[512], l2 = lg[1024], l3 = lg[1536]; const float mx = fmaxf(fmaxf(l0, l1), fmaxf(l2, l3));
            const float e0 = expf(l0 - mx), e1 = expf(l1 - mx), e2 = expf(l2 - mx), e3 = expf(l3 - mx), inv = 1.f / (e0 + e1 + e2 + e3);
            float* lb = (float*)(ws + O_CTL) + (size_t)dir * 4 * 512 + c;
            lb[0] = 0.f; lb[512] = fmaxf(e1 * inv, 0.f); lb[1024] = fmaxf((e1 + e2) * inv, 0.f); lb[1536] = fmaxf((e1 + e2 + e3) * inv, 0.f); }
    }
}

__device__ __forceinline__ void ln_phase(float* Z, bf16_t* XN, const float* gam, const float* bet, int G) {
    const int tid = otid(), lane = tid & 63, wave = tid >> 6;
    const int gw = blockIdx.x * 8 + wave, NGW = G * 8;
    f32x4 gv[4], bv[4];
#pragma unroll
    for (int j = 0; j < 4; ++j) { gv[j] = ((const f32x4*)gam)[lane + 64 * j]; bv[j] = ((const f32x4*)bet)[lane + 64 * j]; }
    for (int m = gw; m < M; m += NGW) {
        f32x4* zr = (f32x4*)(Z + (size_t)m * DM) + lane;
        f32x4 v[4]; float s = 0.f;
#pragma unroll
        for (int j = 0; j < 4; ++j) { v[j] = zr[64 * j]; s += (v[j][0] + v[j][1]) + (v[j][2] + v[j][3]); }
        const float mean = wave_sum(s) * (1.f / DM); float s2 = 0.f;
#pragma unroll
        for (int j = 0; j < 4; ++j) { v[j] = v[j] - mean; s2 += (v[j][0] * v[j][0] + v[j][1] * v[j][1]) + (v[j][2] * v[j][2] + v[j][3] * v[j][3]); }
        const float rstd = 1.f / sqrtf(wave_sum(s2) * (1.f / DM) + LN_EPS);
        u32x2* o8 = (u32x2*)(XN + (size_t)m * DM) + lane;
#pragma unroll
        for (int j = 0; j < 4; ++j) { const f32x4 y = v[j] * rstd * gv[j] + bv[j]; zr[64 * j] = y; u32x2 w; w.x = pk2(y[0], y[1]); w.y = pk2(y[2], y[3]); o8[64 * j] = w; }
    }
}
constexpr int HO_QT = 0, HO_KT = HO_QT + 64 * 136 * 2, HO_QH = HO_KT + 64 * 136 * 2, HO_KTT = HO_QH + 64 * 136 * 2, HO_VT = HO_KTT + 128 * 72 * 2,
              HO_ST = HO_VT + 128 * 72 * 2, HO_PM = HO_ST + 128 * 136 * 2, HO_DV = HO_PM + 64 * 72 * 2, HO_TOT = HO_DV + 512, HO_END = HO_TOT + 8 * 128 * 4;
static_assert(HO_END <= LDS_BYTES, "hgrn lds");
__device__ __forceinline__ int crow(int r, int hi) { return (r & 3) + 8 * (r >> 2) + 4 * hi; }
#define MFMA32(a, b, c) __builtin_amdgcn_mfma_f32_32x32x16_bf16((a), (b), (c), 0, 0, 0)
#define WG_BAR() do { asm volatile("s_waitcnt vmcnt(0) lgkmcnt(0)" ::: "memory"); __builtin_amdgcn_s_barrier(); asm volatile("" ::: "memory"); } while (0)

template <bool OUT>
__device__ __forceinline__ void hgrn_item(LAS unsigned char* lds, const bf16_t* H, const float* lbtab, int layer, int dir, int head, int seg, float* Ust, float* Dseg, float* Odir) {
    const int tid = otid(), w = __builtin_amdgcn_readfirstlane(tid >> 6), lane = tid & 63, l32 = lane & 31, hi = lane >> 5;
    const int chain = dir * 4 + head, c0 = head * 128 + 2 * lane;
    const float lb0 = lbtab[(dir * 4 + layer) * 512 + c0], lb1 = lbtab[(dir * 4 + layer) * 512 + c0 + 1];
    const int ki = w >> 1, vi0 = 2 * (w & 1);
    LAS float* dvec = (LAS float*)(lds + HO_DV); LAS float* tot = (LAS float*)(lds + HO_TOT);
    float* Sg = Ust + ((size_t)(chain * 32 + seg)) * 16384;
    f32x16 S0, S1;
#pragma unroll
    for (int r = 0; r < 16; ++r) { S0[r] = 0.f; S1[r] = 0.f; }
    if (OUT) {
#pragma unroll
        for (int r = 0; r < 16; ++r) { const int k = 32 * ki + crow(r, hi); S0[r] = Sg[k * 128 + 32 * vi0 + l32]; S1[r] = Sg[k * 128 + 32 * (vi0 + 1) + l32]; }
#pragma unroll
        for (int q4 = 0; q4 < 4; ++q4) { const int k = 32 * ki + 8 * q4 + 4 * hi;
            u32x2 a; a.x = pk2(S0[4 * q4], S0[4 * q4 + 1]); a.y = pk2(S0[4 * q4 + 2], S0[4 * q4 + 3]); *(LAS u32x2*)(lds + HO_ST + (32 * vi0 + l32) * 272 + k * 2) = a;
            u32x2 b; b.x = pk2(S1[4 * q4], S1[4 * q4 + 1]); b.y = pk2(S1[4 * q4 + 2], S1[4 * q4 + 3]); *(LAS u32x2*)(lds + HO_ST + (32 * (vi0 + 1) + l32) * 272 + k * 2) = b; }
    }
    float run0 = 0.f, run1 = 0.f;
    const int zoff = dir ? 1536 : 1024;
    for (int c = 0; c < 8; ++c) {
        const int tau0 = seg * 512 + c * 64 + 8 * w;
        float q0[8], q1[8], v0[8], v1[8], k0[8], k1[8], b0[8], b1[8];
#pragma unroll
        for (int i = 0; i < 8; ++i) { const int tau = tau0 + i, t = dir ? (M - 1 - tau) : tau; const bf16_t* row = H + (size_t)t * 3072 + c0;
            const unsigned qq = *(const unsigned*)row, vv = *(const unsigned*)(row + 512), zz = *(const unsigned*)(row + zoff);
            q0[i] = bf2f(qq & 0xffffu); q1[i] = bf2f(qq >> 16); v0[i] = bf2f(vv & 0xffffu); v1[i] = bf2f(vv >> 16);
            const float z0 = fmaxf(bf2f(zz & 0xffffu), -30.f), z1 = fmaxf(bf2f(zz >> 16), -30.f);
            const float e0 = __expf(-z0), e1 = __expf(-z1), s0 = 1.f / (1.f + e0), s1 = 1.f / (1.f + e1);
            k0[i] = (1.f - lb0) * e0 * s0; k1[i] = (1.f - lb1) * e1 * s1;
            const float g0 = __logf(lb0 + (1.f - lb0) * s0), g1 = __logf(lb1 + (1.f - lb1) * s1);
            b0[i] = (i ? b0[i - 1] : 0.f) + g0; b1[i] = (i ? b1[i - 1] : 0.f) + g1; }
        *(LAS f32x2*)(tot + w * 128 + 2 * lane) = (f32x2){b0[7], b1[7]};
        WG_BAR();
        float pre0 = 0.f, pre1 = 0.f, tt0 = 0.f, tt1 = 0.f;
#pragma unroll
        for (int ww = 0; ww < 8; ++ww) { const f32x2 x = *(LAS f32x2*)(tot + ww * 128 + 2 * lane); tt0 += x[0]; tt1 += x[1]; if (ww < w) { pre0 += x[0]; pre1 += x[1]; } }
        const float r0 = 0.5f * tt0, r1 = 0.5f * tt1, d0 = __expf(r0), d1 = __expf(r1);
        run0 += tt0; run1 += tt1;
        {
            unsigned ktw0[4], ktw1[4], vtw0[4], vtw1[4]; float kp0 = 0.f, kp1 = 0.f;
#pragma unroll
            for (int i = 0; i < 8; ++i) { const float bb0 = pre0 + b0[i], bb1 = pre1 + b1[i];
                const float eq0 = __expf(bb0 - r0), eq1 = __expf(bb1 - r1), ek0 = __expf(r0 - bb0), ek1 = __expf(r1 - bb1);
                const int ro = (8 * w + i) * 272 + lane * 4;
                if (OUT) { *(LAS unsigned*)(lds + HO_QT + ro) = pk2(q0[i] * eq0, q1[i] * eq1); *(LAS unsigned*)(lds + HO_KT + ro) = pk2(k0[i] * ek0, k1[i] * ek1);
                           *(LAS unsigned*)(lds + HO_QH + ro) = pk2(q0[i] * eq0 * d0, q1[i] * eq1 * d1); }
                const float kt0 = k0[i] * ek0 * d0, kt1 = k1[i] * ek1 * d1;
                if (i & 1) { ktw0[i >> 1] = pk2(kp0, kt0); ktw1[i >> 1] = pk2(kp1, kt1); vtw0[i >> 1] = pk2(v0[i - 1], v0[i]); vtw1[i >> 1] = pk2(v1[i - 1], v1[i]); }
                else { kp0 = kt0; kp1 = kt1; } }
            *(LAS u32x4*)(lds + HO_KTT + (2 * lane) * 144 + 16 * w) = (u32x4){ktw0[0], ktw0[1], ktw0[2], ktw0[3]};
            *(LAS u32x4*)(lds + HO_KTT + (2 * lane + 1) * 144 + 16 * w) = (u32x4){ktw1[0], ktw1[1], ktw1[2], ktw1[3]};
            *(LAS u32x4*)(lds + HO_VT + (2 * lane) * 144 + 16 * w) = (u32x4){vtw0[0], vtw0[1], vtw0[2], vtw0[3]};
            *(LAS u32x4*)(lds + HO_VT + (2 * lane + 1) * 144 + 16 * w) = (u32x4){vtw1[0], vtw1[1], vtw1[2], vtw1[3]};
        }
        if (w == 0) *(LAS f32x2*)(dvec + 2 * lane) = (f32x2){d0 * d0, d1 * d1};
        WG_BAR();
        f32x16 oacc;
        if (OUT) {
            if (w < 4) {
                const int ti = (w == 0 || w == 3) ? 0 : 1, si = (w >= 2) ? 1 : 0;
                f32x16 p;
#pragma unroll
                for (int r = 0; r < 16; ++r) p[r] = 0.f;
                if (w < 3) {
#pragma unroll
                    for (int kk = 0; kk < 8; ++kk) { const bf16x8 ka = *(LAS bf16x8*)(lds + HO_KT + (32 * si + l32) * 272 + kk * 32 + hi * 16), qb = *(LAS bf16x8*)(lds + HO_QT + (32 * ti + l32) * 272 + kk * 32 + hi * 16);
                        p = MFMA32(ka, qb, p); }
                }
                const int t = 32 * ti + l32;
#pragma unroll
                for (int q4 = 0; q4 < 4; ++q4) { const int s = 32 * si + 8 * q4 + 4 * hi; float x[4];
#pragma unroll
                    for (int e = 0; e < 4; ++e) x[e] = (s + e <= t) ? p[4 * q4 + e] : 0.f;
                    u32x2 o; o.x = pk2(x[0], x[1]); o.y = pk2(x[2], x[3]); *(LAS u32x2*)(lds + HO_PM + t * 144 + s * 2) = o; }
            }
            const int ti = w >> 2, vi = w & 3;
#pragma unroll
            for (int r = 0; r < 16; ++r) oacc[r] = 0.f;
#pragma unroll
            for (int kk = 0; kk < 8; ++kk) { const bf16x8 qa = *(LAS bf16x8*)(lds + HO_QH + (32 * ti + l32) * 272 + kk * 32 + hi * 16), sb = *(LAS bf16x8*)(lds + HO_ST + (32 * vi + l32) * 272 + kk * 32 + hi * 16);
                oacc = MFMA32(qa, sb, oacc); }
        }
#pragma unroll
        for (int q4 = 0; q4 < 4; ++q4) { const f32x4 dv = *(LAS f32x4*)(dvec + 32 * ki + 8 * q4 + 4 * hi);
#pragma unroll
            for (int e = 0; e < 4; ++e) { S0[4 * q4 + e] *= dv[e]; S1[4 * q4 + e] *= dv[e]; } }
#pragma unroll
        for (int kk = 0; kk < 4; ++kk) { const bf16x8 ka = *(LAS bf16x8*)(lds + HO_KTT + (32 * ki + l32) * 144 + kk * 32 + hi * 16);
            const bf16x8 vb0 = *(LAS bf16x8*)(lds + HO_VT + (32 * vi0 + l32) * 144 + kk * 32 + hi * 16), vb1 = *(LAS bf16x8*)(lds + HO_VT + (32 * (vi0 + 1) + l32) * 144 + kk * 32 + hi * 16);
            S0 = MFMA32(ka, vb0, S0); S1 = MFMA32(ka, vb1, S1); }
        WG_BAR();
        if (OUT) {
            const int ti = w >> 2, vi = w & 3;
#pragma unroll
            for (int kk = 0; kk < 4; ++kk) { const bf16x8 pa = *(LAS bf16x8*)(lds + HO_PM + (32 * ti + l32) * 144 + kk * 32 + hi * 16), vb = *(LAS bf16x8*)(lds + HO_VT + (32 * vi + l32) * 144 + kk * 32 + hi * 16);
                oacc = MFMA32(pa, vb, oacc); }
#pragma unroll
            for (int r = 0; r < 16; ++r) { const int tau = seg * 512 + c * 64 + 32 * ti + crow(r, hi), t = dir ? (M - 1 - tau) : tau;
                Odir[(size_t)t * 512 + head * 128 + 32 * vi + l32] = oacc[r]; }
#pragma unroll
            for (int q4 = 0; q4 < 4; ++q4) { const int k = 32 * ki + 8 * q4 + 4 * hi;
                u32x2 a; a.x = pk2(S0[4 * q4], S0[4 * q4 + 1]); a.y = pk2(S0[4 * q4 + 2], S0[4 * q4 + 3]); *(LAS u32x2*)(lds + HO_ST + (32 * vi0 + l32) * 272 + k * 2) = a;
                u32x2 b; b.x = pk2(S1[4 * q4], S1[4 * q4 + 1]); b.y = pk2(S1[4 * q4 + 2], S1[4 * q4 + 3]); *(LAS u32x2*)(lds + HO_ST + (32 * (vi0 + 1) + l32) * 272 + k * 2) = b; }
        }
    }
    if (!OUT) {
#pragma unroll
        for (int r = 0; r < 16; ++r) { const int k = 32 * ki + crow(r, hi); Sg[k * 128 + 32 * vi0 + l32] = S0[r]; Sg[k * 128 + 32 * (vi0 + 1) + l32] = S1[r]; }
        if (w == 0) *(f32x2*)(Dseg + (size_t)(chain * 32 + seg) * 128 + 2 * lane) = (f32x2){__expf(run0), __expf(run1)};
    }
    WG_BAR();
}
__device__ __forceinline__ void hgrn_scan(float* Ust, const float* Dseg, int G) {
    for (int e = blockIdx.x * 512 + threadIdx.x; e < 8 * 16384; e += G * 512) {
        const int chain = e >> 14, el = e & 16383, k = el >> 7; float r = 0.f;
        for (int s = 0; s < 32; ++s) { float* p = Ust + (size_t)(chain * 32 + s) * 16384 + el; const float u = *p; *p = r; r = Dseg[(chain * 32 + s) * 128 + k] * r + u; }
    }
}
__device__ __forceinline__ void hcomb_pool(const bf16_t* H, const float* Of, const float* Ob, const float* ng, bf16_t* CAT, int G) {
    const int tid = otid(), lane = tid & 63, wave = tid >> 6;
    const int gw = blockIdx.x * 8 + wave, NGW = G * 8;
    f32x4 g0 = ((const f32x4*)ng)[2 * lane], g1 = ((const f32x4*)ng)[2 * lane + 1];
    const int grp = lane >> 4, wdw = 2 << grp;
    for (int t = gw; t < M; t += NGW) {
        const f32x4 a0 = ((const f32x4*)(Of + (size_t)t * 512))[2 * lane], a1 = ((const f32x4*)(Of + (size_t)t * 512))[2 * lane + 1];
        const f32x4 c0 = ((const f32x4*)(Ob + (size_t)t * 512))[2 * lane], c1 = ((const f32x4*)(Ob + (size_t)t * 512))[2 * lane + 1];
        const f32x4 o0 = a0 + c0, o1 = a1 + c1;
        float ss = (o0[0] * o0[0] + o0[1] * o0[1]) + (o0[2] * o0[2] + o0[3] * o0[3]) + (o1[0] * o1[0] + o1[1] * o1[1]) + (o1[2] * o1[2] + o1[3] * o1[3]);
        ss += __shfl_xor(ss, 1); ss += __shfl_xor(ss, 2); ss += __shfl_xor(ss, 4); ss += __shfl_xor(ss, 8);
        const float rs = 1.f / sqrtf(ss * (1.f / 128.f) + LN_EPS);
        const u32x4 og = *(const u32x4*)(H + (size_t)t * 3072 + 2048 + 8 * lane);
        float y[8];
#pragma unroll
        for (int e = 0; e < 4; ++e) { y[e] = o0[e] * rs * g0[e]; y[4 + e] = o1[e] * rs * g1[e]; }
#pragma unroll
        for (int e = 0; e < 4; ++e) { const float glo = bf2f(og[e] & 0xffffu), ghi = bf2f(og[e] >> 16); y[2 * e] *= pg8::siluf(glo); y[2 * e + 1] *= pg8::siluf(ghi); }
        u32x4 o; o.x = pk2(y[0], y[1]); o.y = pk2(y[2], y[3]); o.z = pk2(y[4], y[5]); o.w = pk2(y[6], y[7]);
        *(u32x4*)(CAT + (size_t)t * 1024 + 8 * lane) = o;
        int lo = t - (wdw >> 1), hiw = lo + wdw - 1; lo = lo < 0 ? 0 : lo; hiw = hiw > M - 1 ? M - 1 : hiw;
        float sm[8];
#pragma unroll
        for (int e = 0; e < 8; ++e) sm[e] = 0.f;
        for (int tt = lo; tt <= hiw; ++tt) { const u32x4 uu = *(const u32x4*)(H + (size_t)tt * 3072 + 2560 + 8 * lane);
#pragma unroll
            for (int e = 0; e < 4; ++e) { sm[2 * e] += bf2f(uu[e] & 0xffffu); sm[2 * e + 1] += bf2f(uu[e] >> 16); } }
        const u32x4 ut = *(const u32x4*)(H + (size_t)t * 3072 + 2560 + 8 * lane); const float ic = 1.f / (float)(hiw - lo + 1);
        float dl[8];
#pragma unroll
        for (int e = 0; e < 4; ++e) { dl[2 * e] = sm[2 * e] * ic - bf2f(ut[e] & 0xffffu); dl[2 * e + 1] = sm[2 * e + 1] * ic - bf2f(ut[e] >> 16); }
        u32x4 o2; o2.x = pk2(dl[0], dl[1]); o2.y = pk2(dl[2], dl[3]); o2.z = pk2(dl[4], dl[5]); o2.w = pk2(dl[6], dl[7]);
        *(u32x4*)(CAT + (size_t)t * 1024 + 512 + 8 * lane) = o2;
    }
}
__device__ __forceinline__ void qk_prep(const bf16_t* H  , const float* qg, const float* kg, bf16_t* QP  , bf16_t* KP  , int G) {
    const int tid = otid(), lane = tid & 63, wave = tid >> 6;
    const int gw = blockIdx.x * 8 + wave, NGW = G * 8;
    const float fr = __builtin_amdgcn_exp2f(-(float)(lane & 31) * (13.287712379549449f / 32.f)) * 0.15915494309189535f;
    const float qg0 = qg[lane], qg1 = qg[64 + lane], kg0 = kg[lane], kg1 = kg[64 + lane];
    for (int t = gw; t < M; t += NGW) {
        const float ar = (float)(t >> 6) * fr, ac = (float)(t & 63) * fr;
        const float rr = ar - rintf(ar), rc = ac - rintf(ac);
        const float cr = __builtin_amdgcn_cosf(rr), sr = __builtin_amdgcn_sinf(rr), cc = __builtin_amdgcn_cosf(rc), sc = __builtin_amdgcn_sinf(rc);
        const bf16_t* row = H + (size_t)t * 2048;
#pragma unroll
        for (int hh = 0; hh < 6; ++hh) {
            const float x0 = bf2f(row[hh * 128 + lane]), x1 = bf2f(row[hh * 128 + 64 + lane]);
            const float ss = wave_sum(x0 * x0 + x1 * x1), rs = 1.f / sqrtf(ss * (1.f / 128.f) + LN_EPS);
            const float n0 = x0 * rs * (hh < 4 ? qg0 : kg0), n1 = x1 * rs * (hh < 4 ? qg1 : kg1);
            const float p0 = __shfl_xor(n0, 32), p1 = __shfl_xor(n1, 32);
            const float y0 = n0 * cr + (lane < 32 ? -p0 : p0) * sr, y1 = n1 * cc + (lane < 32 ? -p1 : p1) * sc;
            bf16_t* o = hh < 4 ? QP + (size_t)t * 512 + hh * 128 : KP + (size_t)t * 256 + (hh - 4) * 128;
            o[lane] = (bf16_t)(pk2(y0, 0.f) & 0xffffu); o[64 + lane] = (bf16_t)(pk2(y1, 0.f) & 0xffffu);
        }
    }
}
__device__ __forceinline__ void conv_items(LAS unsigned char* lds, const bf16_t* H, const float* cw, const float* cb, const float* lg, const float* lbv, bf16_t* CAT, int G) {
    const int c = otid(), lane = c & 63, wave = c >> 6;
    LAS float* part = (LAS float*)lds;
    float wt[31];
#pragma unroll
    for (int k = 0; k < 31; ++k) wt[k] = cw[k * 512 + c];
    const float bias = cb[c], gmm = lg[c], bta = lbv[c];
    for (int it = blockIdx.x; it < M / 16; it += G) {
        const int t0 = it * 16;
        float u[46];
#pragma unroll
        for (int r = 0; r < 46; ++r) { const int t = t0 - 15 + r; float x = 0.f;
            if (t >= 0 && t < M) { const float val = bf2f(H[(size_t)t * 2048 + 1024 + c]), gate = bf2f(H[(size_t)t * 2048 + 1536 + c]); x = val * __builtin_amdgcn_rcpf(1.f + __expf(-gate)); }
            u[r] = x; }
        float acc[16];
#pragma unroll
        for (int i = 0; i < 16; ++i) { float s = bias;
#pragma unroll
            for (int k = 0; k < 31; ++k) s += wt[k] * u[i + k];
            acc[i] = s; }
#pragma unroll
        for (int i = 0; i < 16; ++i) { const float s = wave_sum(acc[i]), s2 = wave_sum(acc[i] * acc[i]); if (lane == 0) *(LAS f32x2*)(part + (i * 8 + wave) * 2) = (f32x2){s, s2}; }
        WG_BAR();
#pragma unroll
        for (int i = 0; i < 16; ++i) { float s = 0.f, s2 = 0.f;
#pragma unroll
            for (int ww = 0; ww < 8; ww += 2) { const f32x4 p = *(LAS f32x4*)(part + (i * 8 + ww) * 2); s += p[0] + p[2]; s2 += p[1] + p[3]; }
            const float mean = s * (1.f / 512.f), var = fmaxf(s2 * (1.f / 512.f) - mean * mean, 0.f), rstd = 1.f / sqrtf(var + LN_EPS);
            const float y = (acc[i] - mean) * rstd * gmm + bta;
            CAT[(size_t)(t0 + i) * 1024 + 512 + c] = (bf16_t)(pk2(pg8::siluf(y), 0.f) & 0xffffu); }
        WG_BAR();
    }
}

namespace att {
constexpr int D = 128, NW = 8, QBLK = 32, KVBLK = 64;
constexpr float SCALE = 0.088388347648318440f, THR = 8.f;
constexpr int LDQ = 512, LDK = 256, LDV = 2048, LDO = 1024;
constexpr size_t SHM_V = KVBLK * D * 2, SHM_K = KVBLK * D * 2, SHM_ATTN = 2 * SHM_V + 2 * SHM_K + NW * 64 * 4;
#define KSWZ(row, colB) ((row) * 256 + ((colB) ^ (((row) & 7) << 4)))
#define SBAR() __builtin_amdgcn_sched_barrier(0)
__device__ __forceinline__ unsigned cvtpk(float lo, float hi) { unsigned r; asm volatile("v_cvt_pk_bf16_f32 %0, %1, %2" : "=v"(r) : "v"(lo), "v"(hi)); return r; }
__device__ __forceinline__ void partialSM(f32x16& p0, f32x16& p1, float& m_reg, float& mn, float& alpha) {
  constexpr float C = SCALE * 1.4426950408889634f;
  float pmax = p0[0]; for (int r = 1; r < 16; ++r) pmax = fmaxf(pmax, p0[r]); for (int r = 0; r < 16; ++r) pmax = fmaxf(pmax, p1[r]);
  { auto rr = __builtin_amdgcn_permlane32_swap(__float_as_uint(pmax), __float_as_uint(pmax), false, false);
    pmax = fmaxf(__uint_as_float(rr[0]), __uint_as_float(rr[1])); }
  if (__builtin_expect(__all(pmax - m_reg <= THR / SCALE), 1)) { mn = m_reg; alpha = 1.f; }
  else { mn = fmaxf(m_reg, pmax); alpha = __builtin_amdgcn_exp2f((m_reg - mn) * C); m_reg = mn; }
  float mnC = -mn * C;
  for (int r = 0; r < 16; ++r) p0[r] = fmaf(p0[r], C, mnC); for (int r = 0; r < 16; ++r) p1[r] = fmaf(p1[r], C, mnC);
  for (int r = 0; r < 16; ++r) p0[r] = __builtin_amdgcn_exp2f(p0[r]);
}
__device__ __forceinline__ void finishSM(f32x16& p0, f32x16& p1, float alpha, float& l_reg, bf16x8& pa0, bf16x8& pa1, bf16x8& pa2, bf16x8& pa3) {
  for (int r = 0; r < 16; ++r) p1[r] = __builtin_amdgcn_exp2f(p1[r]);
  float ps = 0; for (int r = 0; r < 16; ++r) ps += p0[r]; for (int r = 0; r < 16; ++r) ps += p1[r];
  { auto rr = __builtin_amdgcn_permlane32_swap(__float_as_uint(ps), __float_as_uint(ps), false, false);
    ps = __uint_as_float(rr[0]) + __uint_as_float(rr[1]); }
  l_reg = l_reg * alpha + ps;
#define PK4(P, BASE, OUT) do { unsigned a0 = cvtpk(P[BASE + 0], P[BASE + 1]), a1 = cvtpk(P[BASE + 2], P[BASE + 3]);   \
    unsigned b0 = cvtpk(P[BASE + 4], P[BASE + 5]), b1 = cvtpk(P[BASE + 6], P[BASE + 7]);                              \
    auto r0 = __builtin_amdgcn_permlane32_swap(a0, b0, false, false); auto r1 = __builtin_amdgcn_permlane32_swap(a1, b1, false, false); \
    u32x4 w = {r0[0], r1[0], r0[1], r1[1]}; OUT = *reinterpret_cast<bf16x8*>(&w); } while (0)
  PK4(p0, 0, pa0); PK4(p0, 8, pa1); PK4(p1, 0, pa2); PK4(p1, 8, pa3);
#undef PK4
}
__device__ __forceinline__ void qkt(f32x16& p0, f32x16& p1, const bf16_t* Ks, const bf16x8* qr, int r32, int hi) {
  p0 = f32x16{}; p1 = f32x16{};
  for (int d0 = 0; d0 < 8; ++d0) { int cb = (d0 * 16 + hi * 8) * 2;
    bf16x8 b0 = *reinterpret_cast<const bf16x8*>((const char*)Ks + KSWZ(r32, cb));
    bf16x8 b1 = *reinterpret_cast<const bf16x8*>((const char*)Ks + KSWZ(32 + r32, cb));
    p0 = __builtin_amdgcn_mfma_f32_32x32x16_bf16(b0, qr[d0], p0, 0, 0, 0);
    p1 = __builtin_amdgcn_mfma_f32_32x32x16_bf16(b1, qr[d0], p1, 0, 0, 0); }
}
__device__ __forceinline__ int v_st(int k, int c) { const int kk = (k & ~0xC) | ((k & 4) << 1) | ((k & 8) >> 1); return ((kk >> 3) * 4 + (c >> 5)) * 512 + ((kk & 7) * 32 + (c & 31)) * 2; }
__device__ __forceinline__ int v_rd_base(int lane) { return ((lane & 3) << 3) | (((lane >> 2) & 3) << 6) | (((lane >> 4) & 1) << 5) | (((lane >> 5) & 1) << 8); }
constexpr int v_rd_off(int d0, int ks, int half) { return d0 * 512 + ks * 4096 + half * 2048; }
template <int OFF> __device__ __forceinline__ s16x4 tr_read(int vb) {
  s16x4 r; asm volatile("ds_read_b64_tr_b16 %0, %1 offset:%2" : "=&v"(r) : "v"(vb), "i"(OFF) : "memory"); return r;
}
template <int D0> __device__ __forceinline__ void pv_one(f32x16& od, int vb, bf16x8 pa0, bf16x8 pa1, bf16x8 pa2, bf16x8 pa3) {
  const s16x4 l0 = tr_read<v_rd_off(D0, 0, 0)>(vb), h0 = tr_read<v_rd_off(D0, 0, 1)>(vb), l1 = tr_read<v_rd_off(D0, 1, 0)>(vb), h1 = tr_read<v_rd_off(D0, 1, 1)>(vb);
  const s16x4 l2 = tr_read<v_rd_off(D0, 2, 0)>(vb), h2 = tr_read<v_rd_off(D0, 2, 1)>(vb), l3 = tr_read<v_rd_off(D0, 3, 0)>(vb), h3 = tr_read<v_rd_off(D0, 3, 1)>(vb);
  asm volatile("s_waitcnt lgkmcnt(0)" ::: "memory"); SBAR();
#define PK(L, H) (bf16x8){L[0], L[1], L[2], L[3], H[0], H[1], H[2], H[3]}
  od = __builtin_amdgcn_mfma_f32_32x32x16_bf16(pa0, PK(l0, h0), od, 0, 0, 0);
  od = __builtin_amdgcn_mfma_f32_32x32x16_bf16(pa1, PK(l1, h1), od, 0, 0, 0);
  od = __builtin_amdgcn_mfma_f32_32x32x16_bf16(pa2, PK(l2, h2), od, 0, 0, 0);
  od = __builtin_amdgcn_mfma_f32_32x32x16_bf16(pa3, PK(l3, h3), od, 0, 0, 0);
#undef PK
}
__device__ __forceinline__ void pv_d0(f32x16* o, int vb, bf16x8 pa0, bf16x8 pa1, bf16x8 pa2, bf16x8 pa3) {
  pv_one<0>(o[0], vb, pa0, pa1, pa2, pa3); pv_one<1>(o[1], vb, pa0, pa1, pa2, pa3); pv_one<2>(o[2], vb, pa0, pa1, pa2, pa3); pv_one<3>(o[3], vb, pa0, pa1, pa2, pa3);
}
__device__ __forceinline__ void attn_dense_body(const bf16_t* __restrict__ Qb, const bf16_t* __restrict__ Kh, const bf16_t* __restrict__ Vh, bf16_t* __restrict__ Ob, int seq, char* lds) {
  const int tid = otid(), wid = tid >> 6, lane = tid & 63, r32 = lane & 31, hi = lane >> 5;
  bf16_t* V_lds = (bf16_t*)lds; bf16_t* K_lds = (bf16_t*)(lds + 2 * SHM_V);
  float* ws = (float*)(lds + 2 * SHM_V + 2 * SHM_K) + wid * 64; float* li_l = ws; float* al_l = ws + 32;
  float m_reg = -1e30f, l_reg = 0; f32x16 o[4] = {}; bf16x8 qr[8];
  const bf16_t* Qw = Qb + (long)(wid * QBLK + r32) * LDQ + hi * 8;
#pragma unroll
  for (int d0 = 0; d0 < 8; ++d0) qr[d0] = *reinterpret_cast<const bf16x8*>(Qw + d0 * 16);
  const int sr = tid >> 4, sc = (tid & 15) * 8, vst0 = v_st(sr, sc), vst1 = v_st(32 + sr, sc);
  const int vb0 = (int)(uintptr_t)V_lds + v_rd_base(lane);
  struct { bf16x8 vs0, vs1, ks0, ks1; } sr_[2];
#define LD8(p) (*reinterpret_cast<const bf16x8*>(p))
#define SLOAD(i, k0) do { sr_[i].vs0 = LD8(&Vh[(long)((k0) + sr) * LDV + sc]); sr_[i].vs1 = LD8(&Vh[(long)((k0) + 32 + sr) * LDV + sc]); \
    sr_[i].ks0 = LD8(&Kh[(long)((k0) + sr) * LDK + sc]); sr_[i].ks1 = LD8(&Kh[(long)((k0) + 32 + sr) * LDK + sc]); } while (0)
#define SWRITE(b, i) do { *(bf16x8*)((char*)V_lds + (b) * SHM_V + vst0) = sr_[i].vs0;          \
    *(bf16x8*)((char*)V_lds + (b) * SHM_V + vst1) = sr_[i].vs1; int kc = sc * 2;               \
    *(bf16x8*)((char*)K_lds + (b) * SHM_K + KSWZ(sr, kc)) = sr_[i].ks0;                       \
    *(bf16x8*)((char*)K_lds + (b) * SHM_K + KSWZ(32 + sr, kc)) = sr_[i].ks1; } while (0)
#define SWAIT() asm volatile("s_waitcnt vmcnt(4)" ::: "memory")
#define RESC(a) do { if (__any((a) < 1.f)) { if (hi == 0) al_l[r32] = (a); asm volatile("s_waitcnt lgkmcnt(0)" ::: "memory"); \
    for (int d = 0; d < 4; ++d) for (int r = 0; r < 16; ++r) o[d][r] *= al_l[crow(r, hi)]; } } while (0)
  f32x16 pA0, pA1, pB0, pB1; float mnA, mnB, alA, alB; bf16x8 pa0, pa1, pa2, pa3; const int NT = seq / KVBLK;
  constexpr int SE = 0, SO = 1;
  SLOAD(SE, 0); asm volatile("s_waitcnt vmcnt(0)" ::: "memory"); SWRITE(0, SE); __syncthreads();
  qkt(pA0, pA1, K_lds, qr, r32, hi); partialSM(pA0, pA1, m_reg, mnA, alA);
  SLOAD(SO, KVBLK); if (2 < NT) SLOAD(SE, 2 * KVBLK);
  SWAIT(); SWRITE(1, SO); __syncthreads();
  for (int j = 1; j + 1 < NT; j += 2) {
    SBAR(); qkt(pB0, pB1, (bf16_t*)((char*)K_lds + SHM_K), qr, r32, hi);
    finishSM(pA0, pA1, alA, l_reg, pa0, pa1, pa2, pa3); SBAR();
    SLOAD(SO, (j + 2) * KVBLK); SBAR();
    pv_d0(o, vb0, pa0, pa1, pa2, pa3); partialSM(pB0, pB1, m_reg, mnB, alB);
    __syncthreads(); SWAIT(); SWRITE(0, SE);
    RESC(alB); __syncthreads();
    SBAR(); qkt(pA0, pA1, K_lds, qr, r32, hi);
    finishSM(pB0, pB1, alB, l_reg, pa0, pa1, pa2, pa3); SBAR();
    if (j + 3 < NT) SLOAD(SE, (j + 3) * KVBLK); SBAR();
    pv_d0(o, vb0 + (int)SHM_V, pa0, pa1, pa2, pa3); partialSM(pA0, pA1, m_reg, mnA, alA);
    __syncthreads(); SWAIT(); SWRITE(1, SO);
    RESC(alA); __syncthreads();
  }
  SBAR(); qkt(pB0, pB1, (bf16_t*)((char*)K_lds + SHM_K), qr, r32, hi);
  finishSM(pA0, pA1, alA, l_reg, pa0, pa1, pa2, pa3); SBAR();
  pv_d0(o, vb0, pa0, pa1, pa2, pa3); partialSM(pB0, pB1, m_reg, mnB, alB);
  __syncthreads(); RESC(alB);
  finishSM(pB0, pB1, alB, l_reg, pa0, pa1, pa2, pa3); SBAR();
  pv_d0(o, vb0 + (int)SHM_V, pa0, pa1, pa2, pa3);
  if (hi == 0) li_l[r32] = l_reg; asm volatile("s_waitcnt lgkmcnt(0)" ::: "memory");
  float rli[16];
#pragma unroll
  for (int r = 0; r < 16; ++r) rli[r] = __builtin_amdgcn_rcpf(li_l[crow(r, hi)]);
  bf16_t* Ow = Ob + (long)(wid * QBLK) * LDO;
#pragma unroll
  for (int r = 0; r < 16; ++r) { int orow = crow(r, hi);
    for (int d0 = 0; d0 < 4; ++d0) Ow[(long)orow * LDO + d0 * 32 + r32] = (bf16_t)(cvtpk(o[d0][r] * rli[r], 0.f) & 0xffffu); }
#undef SLOAD
#undef SWRITE
#undef SWAIT
#undef RESC
#undef LD8
}
}
enum { K_STORE = 1, K_SOFTMAX, K_SWIGLU, K_RESID, K_LN, K_H1, K_HSCAN, K_H2, K_HCOMB, K_PREP, K_ATTN };
constexpr unsigned long long PROG_EVEN = 0x1ull | (0x6ull << 4) | (0x7ull << 8) | (0x8ull << 12) | (0x9ull << 16) | (0x4ull << 20) | (0x5ull << 24) | (0x1ull << 28) | (0x2ull << 32) | (0x1ull << 36) |
                                         (0x4ull << 40) | (0x5ull << 44) | (0x3ull << 48) | (0x4ull << 52) | (0x5ull << 56);
constexpr unsigned long long PROG_ODD = 0x1ull | (0xAull << 4) | (0xBull << 8) | (0x4ull << 12) | (0x5ull << 16) | (0x1ull << 20) | (0x2ull << 24) | (0x1ull << 28) | (0x4ull << 32) | (0x5ull << 36) |
                                        (0x3ull << 40) | (0x4ull << 44) | (0x5ull << 48);

__global__ void __launch_bounds__(512, 2) mega(Args a) {
    extern __shared__ __attribute__((aligned(16))) unsigned char lds_raw[];
    LAS unsigned char* lds = (LAS unsigned char*)lds_raw;
    cg::grid_group grid = cg::this_grid();
    const int G = gridDim.x, bx = blockIdx.x;
    unsigned char* ws = a.ws;
    bf16_t* const Hb = (bf16_t*)(ws + O_H); bf16_t* const CAT = (bf16_t*)(ws + O_CAT); bf16_t* const XN = (bf16_t*)(ws + O_XN);
    bf16_t* const XQ = Hb; bf16_t* const XP = Hb + (size_t)M * 1024; bf16_t* const XO = Hb + 2 * (size_t)M * 1024;
    float* const OF = (float*)(ws + O_OF); float* const OB = (float*)(ws + O_XN);
    bf16_t* const QP = (bf16_t*)(ws + O_OF); bf16_t* const KP = QP + (size_t)M * 512;
    float* const UST = (float*)(ws + O_ST); float* const LBT = (float*)(ws + O_CTL); float* const DSEG = (float*)(ws + O_CTL + 65536);
    float* const X = a.out;

#ifndef NO_PRO
    prologue(a, lds, G);
#endif
    grid.sync();

    for (int l = 0; l < 4; ++l) {
        const int j = l >> 1; const bool odd = l & 1;
        const unsigned long long prog = odd ? PROG_ODD : PROG_EVEN; const int nsteps = odd ? 13 : 15;
        int n_store = 0, n_resid = 0, n_ln = 0;
        for (int st = 0; st < nsteps; ++st) {
            const int kind = (int)((prog >> (4 * st)) & 15ull);
            if (kind == K_STORE) {
#ifndef NO_STORE
                const int nsub = (l == 0 && n_store == 0) ? 9 : 1;
                for (int sub = 0; sub < nsub; ++sub) {
                    pg8::Gemm g; pg8::EpiStore E; int c = bx;
                    if (sub == 0) {
                        if (n_store == 0) {
                            if (!odd) { g = pg8::Gemm{XN, (const bf16_t*)(ws + O_WAB) + (size_t)j * 3072 * 1024, M, 3072, 1024, 1024, 1024, 0, 256 * 1024}; E = pg8::EpiStore{Hb, 3072, 512, 1.f}; }
                            else      { g = pg8::Gemm{XN, (const bf16_t*)(ws + O_WCD) + (size_t)j * 2048 * 1024, M, 2048, 1024, 1024, 1024, 0, 256 * 1024}; E = pg8::EpiStore{Hb, 2048, 0, 1.f}; }
                        } else if (n_store == 1) {
                            g = pg8::Gemm{XN, (const bf16_t*)(ws + O_WQ) + (size_t)l * 1024 * 1024, M, 1024, 1024, 1024, 1024, 0, 256 * 1024}; E = pg8::EpiStore{XQ, 1024, 0, 0.0625f * 1.4426950408889634f};
                        } else {
                            g = pg8::Gemm{XP, (const bf16_t*)(ws + O_XVT) + (size_t)l * 1024 * 256, M, 1024, 256, 1024, 256, 256, 256 * 256}; E = pg8::EpiStore{XO, 1024, 0, 1.f};
                        }
                    } else if (sub <= 4) {
                        const int ll = sub - 1; c = (bx + G - 4 * sub) % G;
                        g = pg8::Gemm{(const bf16_t*)(ws + O_MEMB), (const bf16_t*)(ws + O_WKV) + (size_t)ll * 2048 * 1024, 256, 1024, 1024, 1024, 1024, 0, 256 * 1024}; E = pg8::EpiStore{(bf16_t*)(ws + O_XK) + (size_t)ll * 256 * 1024, 1024, 0, 1.f};
                    } else {
                        const int ll = sub - 5; c = (bx + G - 4 * sub) % G;
                        g = pg8::Gemm{(const bf16_t*)(ws + O_WKV) + (size_t)ll * 2048 * 1024 + (size_t)1024 * 1024, (const bf16_t*)(ws + O_MEMB), 1024, 256, 1024, 1024, 1024, 0, 256 * 1024}; E = pg8::EpiStore{(bf16_t*)(ws + O_XVT) + (size_t)ll * 1024 * 256, 256, 0, 1.f};
                    }
                    pg8::StaticOrder S; S.init(g.M, g.N, G, c);
                    pg8::gemm_phase<pg8::EpiStore, pg8::StaticOrder, true, true>(lds, g, S, E);
                }
#endif
                ++n_store;
            } else if (kind == K_SOFTMAX) {
                pg8::Gemm g{XQ, (const bf16_t*)(ws + O_XK) + (size_t)l * 256 * 1024, M, 1024, 256, 1024, 1024, 256, 256};
                pg8::EpiSoftmax E{XP}; pg8::StaticOrder S; S.init(M, 1024, G, bx);

#ifndef NO_SOFTMAX
 pg8::gemm_phase<pg8::EpiSoftmax, pg8::StaticOrder, false, true>(lds, g, S, E);
#endif

            } else if (kind == K_SWIGLU) {
                pg8::Gemm g{XN, (const bf16_t*)(ws + O_WGU) + (size_t)l * 5632 * 1024, M, 5632, 1024, 1024, 1024, 0, 256 * 1024};
                pg8::EpiSwiGLU E{Hb, DFF}; pg8::StaticOrder S; S.init(M, 5632, G, bx);

#ifndef NO_SWIGLU
 pg8::gemm_phase<pg8::EpiSwiGLU, pg8::StaticOrder, true, true>(lds, g, S, E);
#endif

            } else if (kind == K_RESID) {
                pg8::Gemm g;
                if (n_resid == 0) g = pg8::Gemm{CAT, (const bf16_t*)(ws + (odd ? O_WOCD : O_WOAB)) + (size_t)j * 1024 * 1024, M, 1024, 1024, 1024, 1024, 0, 256 * 1024};
                else if (n_resid == 1) g = pg8::Gemm{XO, (const bf16_t*)(ws + O_WO) + (size_t)l * 1024 * 1024, M, 1024, 1024, 1024, 1024, 0, 256 * 1024};
                else g = pg8::Gemm{Hb, (const bf16_t*)(ws + O_WDN) + (size_t)l * 1024 * 2816, M, 1024, 2816, 2816, 2816, 0, 256 * 2816};
                pg8::EpiResid E{(l == 0 && n_resid == 0) ? a.in[0] : X, X, ALPHA}; pg8::StaticOrder S; S.init(M, 1024, G, bx);

#ifndef NO_RESID
 pg8::gemm_phase<pg8::EpiResid, pg8::StaticOrder, true, true>(lds, g, S, E);
#endif

                ++n_resid;
            } else if (kind == K_LN) {
                ln_phase(X, XN, a.in[21] + (size_t)(l * 3 + n_ln) * 1024, a.in[22] + (size_t)(l * 3 + n_ln) * 1024, G);
                ++n_ln;
            } else if (kind == K_H1) {

#ifndef NO_H1
 for (int it = bx; it < 256; it += G) hgrn_item<false>(lds, Hb, LBT, l, it >> 7, (it >> 5) & 3, it & 31, UST, DSEG, nullptr);
#endif

            } else if (kind == K_HSCAN) {
                hgrn_scan(UST, DSEG, G);
            } else if (kind == K_H2) {

#ifndef NO_H2
 for (int it = bx; it < 256; it += G) hgrn_item<true>(lds, Hb, LBT, l, it >> 7, (it >> 5) & 3, it & 31, UST, DSEG, (it >> 7) ? OB : OF);
#endif

            } else if (kind == K_HCOMB) {

#ifndef NO_HCOMB
                hcomb_pool(Hb, OF, OB, a.in[4] + (size_t)j * 512, CAT, G);
#endif

            } else if (kind == K_PREP) {

#ifndef NO_CONV
                conv_items(lds, Hb, a.in[11] + (size_t)j * 31 * 512, a.in[12] + (size_t)j * 512, a.in[13] + (size_t)j * 512, a.in[14] + (size_t)j * 512, CAT, G);
#endif
#ifndef NO_QKP

                qk_prep(Hb, a.in[9] + (size_t)j * 128, a.in[10] + (size_t)j * 128, QP, KP, G);
#endif
            } else if (kind == K_ATTN) {

#ifndef NO_ATTN
                for (int u = bx; u < 256; u += G) { const int h = u & 3, qb = u >> 2, kvh = h >> 1;
                    att::attn_dense_body(QP + (size_t)qb * 256 * 512 + h * 128, KP + kvh * 128, Hb + 768 + kvh * 128, CAT + (size_t)qb * 256 * 1024 + h * 128, M, (char*)lds_raw);
                    __syncthreads(); }
#endif
            }
            grid.sync();
        }
    }
}

extern "C" void kernel_launch(void* const* d_in, const int* in_sizes, int n_in, void* d_out, int out_size, void* d_ws, size_t ws_size, hipStream_t stream) {
    static int grid = 0;
    if (grid == 0) {
        if (n_in != 23 || out_size != M * DM || ws_size < O_END) { fprintf(stderr, "kernel_launch: unexpected shapes: n_in %d out %d ws %zu (need %zu)\n", n_in, out_size, ws_size, (size_t)O_END); grid = -1; return; }
        if (hipFuncSetAttribute((const void*)mega, hipFuncAttributeMaxDynamicSharedMemorySize, LDS_BYTES) != hipSuccess) { fprintf(stderr, "kernel_launch: hipFuncSetAttribute failed\n"); grid = -1; return; }
        int dev = 0, cus = 0, per = 0;
        if (hipGetDevice(&dev) != hipSuccess || hipDeviceGetAttribute(&cus, hipDeviceAttributeMultiprocessorCount, dev) != hipSuccess) { grid = -1; return; }
        if (hipOccupancyMaxActiveBlocksPerMultiprocessor(&per, (const void*)mega, 512, LDS_BYTES) != hipSuccess || per < 1) { fprintf(stderr, "kernel_launch: occupancy query says %d\n", per); (void)hipGetLastError(); }
        grid = cus;
        if (grid != 256) fprintf(stderr, "kernel_launch: %d CUs; this kernel expects 256\n", grid);
    }
    if (grid < 0) return;
    Args a{};
    for (int i = 0; i < 23; ++i) a.in[i] = (const float*)d_in[i];
    a.out = (float*)d_out; a.ws = (unsigned char*)d_ws;
    void* args[] = {&a};
    hipError_t e = hipLaunchCooperativeKernel((const void*)mega, dim3(grid), dim3(512), args, LDS_BYTES, stream);
    if (e != hipSuccess) fprintf(stderr, "kernel_launch: cooperative launch failed: %s\n", hipGetErrorString(e));
}
```

```cpp
#include <hip/hip_runtime.h>
#include <hip/hip_cooperative_groups.h>
#include <cstdio>
#include <cstdint>
namespace cg = cooperative_groups;
__device__ __forceinline__ int otid() { int t = threadIdx.x; asm volatile("" : "+v"(t)); return t; }
namespace pg8 {
#define PG8_LAS __attribute__((address_space(3)))
typedef unsigned short bf16_t;
typedef short bf16x8 __attribute__((ext_vector_type(8)));
typedef float f32x4 __attribute__((ext_vector_type(4)));
typedef unsigned u32x4 __attribute__((ext_vector_type(4)));
constexpr int BM = 256, BK = 64, HALF = 128, HTB = HALF * BK * 2  , STAGE_BYTES = 8 * HTB, NXCD = 8, WGM = 8;

__host__ __device__ __forceinline__ int lds_byte(int r, int c) { const int st = (r >> 4) * 2 + (c >> 5), rr = r & 15, cc = c & 31, ob = rr * 64 + cc * 2; return st * 1024 + (ob ^ (((ob >> 9) & 1) << 5)); }
__host__ __device__ __forceinline__ void stage_rc(int b, int& R, int& C) { const int st = b / 1024, sb = b % 1024, swz = sb ^ (((sb >> 9) & 1) << 5); R = (st >> 1) * 16 + swz / 64; C = (st & 1) * 32 + (swz % 64) / 2; }
__host__ __device__ __forceinline__ int perm32(int rho) { const int n = rho >> 4, i = rho & 15; return 8 * (i >> 2) + 4 * n + (i & 3); }

struct Unit { int pm, pn; };
struct Gemm { const bf16_t* A; const bf16_t* Bt; int M, N, K, lda, ldb; long a_pn, b_pn; };

struct StaticOrder {
    int nM, nN, nwg, G, c;
    __host__ __device__ void init(int M, int N, int G_, int c_) { nM = M / BM; nN = N / BM; nwg = nM * nN; G = G_; c = c_; }
    __host__ __device__ bool next(int i, Unit& u) const {
        const long L = (long)i * G + c; if (L >= nwg) return false;
        int wgid = (int)L; { const int q = nwg / NXCD, r = nwg % NXCD, xcd = wgid % NXCD, off = wgid / NXCD; wgid = (xcd < r ? xcd * (q + 1) : r * (q + 1) + (xcd - r) * q) + off; }
        const int nig = WGM * nN, gid = wgid / nig, fm = gid * WGM, gsz = (nM - fm) < WGM ? (nM - fm) : WGM;
        u.pm = fm + ((wgid % nig) % gsz); u.pn = (wgid % nig) / gsz; return true;
    }
    __device__ __forceinline__ void a_ready(const Unit&) const {}
    __device__ __forceinline__ void done(const Unit&) const {}
};


template <class Epi, class Sched, bool ALIGN_EPI = false, bool SP2 = false>
__device__ __forceinline__ void gemm_phase(PG8_LAS unsigned char* lds, const Gemm g, const Sched& S, const Epi& E) {
    const int tid = otid(), wid = __builtin_amdgcn_readfirstlane(tid >> 6), lane = tid & 63, wr = wid >> 2, wc = wid & 3, fr = lane & 15, fq = lane >> 4;
    const int K = g.K, nt = K / BK;
    unsigned voffA[2], voffB[2];
#pragma unroll
    for (int i = 0; i < 2; ++i) { int R, C; stage_rc(tid * 16 + i * 8192, R, C); const int Rb = Epi::PERM ? ((R & ~31) + perm32(R & 31)) : R;
        voffA[i] = (unsigned)(R * g.lda + C) * 2u; voffB[i] = (unsigned)(Rb * g.ldb + C) * 2u; }
    const size_t kstep = (size_t)(BK * 2);
    const size_t hA = (size_t)HALF * g.lda * 2, hB = (size_t)HALF * g.ldb * 2;
    const unsigned ldsw = (unsigned)wid * 1024u;
    const int aoff = lds_byte(wr * 64 + fr, fq * 8), boff = lds_byte(wc * 32 + fr, fq * 8);
#define PG8_AOF(u) ((const char*)g.A + ((size_t)(u).pm * 256 * g.lda + (size_t)(u).pn * g.a_pn) * 2)
#define PG8_BOF(u) ((const char*)g.Bt + (size_t)(u).pn * g.b_pn * 2)
#define PG8_SA(b, h) (((b) * 2 + (h)) * HTB)
#define PG8_SB(b, h) ((4 + (b) * 2 + (h)) * HTB)
#define PG8_STAGE(bufoff, gbase, voff) do { _Pragma("unroll") for (int _i = 0; _i < 2; ++_i) \
        __builtin_amdgcn_global_load_lds((const unsigned*)((const char*)(gbase) + (voff)[_i]), (PG8_LAS unsigned*)(lds + (bufoff) + ldsw + _i * 8192), 16, 0, 0); } while (0)
#define PG8_LDA(dst, b, h) do { _Pragma("unroll") for (int m = 0; m < 4; ++m) _Pragma("unroll") for (int k = 0; k < 2; ++k) dst[m][k] = *(const PG8_LAS bf16x8*)(lds + PG8_SA(b, h) + aoff + m * 2048 + k * 1024); } while (0)
#define PG8_LDB(dst, b, h) do { _Pragma("unroll") for (int n = 0; n < 2; ++n) _Pragma("unroll") for (int k = 0; k < 2; ++k) dst[n][k] = *(const PG8_LAS bf16x8*)(lds + PG8_SB(b, h) + boff + n * 2048 + k * 1024); } while (0)
#define PG8_MMA(ai, bj, At, Bt) do { __builtin_amdgcn_s_setprio(1); _Pragma("unroll") for (int m = 0; m < 4; ++m) _Pragma("unroll") for (int n = 0; n < 2; ++n) _Pragma("unroll") for (int k = 0; k < 2; ++k) \
        acc[ai][bj][m][n] = __builtin_amdgcn_mfma_f32_16x16x32_bf16(Bt[n][k], At[m][k], acc[ai][bj][m][n], 0, 0, 0); __builtin_amdgcn_s_setprio(0); } while (0)
#define PG8_WAIT_V(n) asm volatile("s_waitcnt vmcnt(" #n ")" ::: "memory")
#define PG8_WAIT_L(n) asm volatile("s_waitcnt lgkmcnt(" #n ")" ::: "memory")
#define PG8_BAR __builtin_amdgcn_s_barrier()
#define PG8_SCHED __builtin_amdgcn_sched_barrier(0)
    Unit cur, nxt; int ui = 0;
    if (!S.next(0, cur)) return;
    f32x4 acc[2][2][4][2];
#pragma unroll
    for (int a = 0; a < 2; ++a)
#pragma unroll
        for (int b = 0; b < 2; ++b)
#pragma unroll
            for (int m = 0; m < 4; ++m)
#pragma unroll
                for (int n = 0; n < 2; ++n) acc[a][b][m][n] = (f32x4){0.f, 0.f, 0.f, 0.f};
    bf16x8 At[4][2], B0[2][2], B1[2][2];
    const char* cA = PG8_AOF(cur); const char* cB = PG8_BOF(cur);
    S.a_ready(cur);
    if constexpr (SP2) {
        PG8_STAGE(PG8_SB(0, 0), cB, voffB); PG8_STAGE(PG8_SB(0, 1), cB + hB, voffB); PG8_STAGE(PG8_SA(0, 0), cA, voffA); PG8_STAGE(PG8_SA(0, 1), cA + hA, voffA);
        if (wr == 1) PG8_BAR;
        PG8_WAIT_V(2); PG8_BAR;
        PG8_STAGE(PG8_SB(1, 0), cB + kstep, voffB); PG8_STAGE(PG8_SA(1, 0), cA + kstep, voffA); PG8_STAGE(PG8_SB(1, 1), cB + hB + kstep, voffB);
        PG8_WAIT_V(6); PG8_BAR;
    } else {
        PG8_STAGE(PG8_SB(0, 0), cB, voffB); PG8_STAGE(PG8_SA(0, 0), cA, voffA); PG8_STAGE(PG8_SB(0, 1), cB + hB, voffB); PG8_STAGE(PG8_SA(0, 1), cA + hA, voffA);
        if (wr == 1) PG8_BAR;
        PG8_WAIT_V(4); PG8_BAR;
        PG8_STAGE(PG8_SB(1, 0), cB + kstep, voffB); PG8_STAGE(PG8_SA(1, 0), cA + kstep, voffA); PG8_STAGE(PG8_SB(1, 1), cB + hB + kstep, voffB);
        PG8_WAIT_V(6); PG8_BAR;
    }
    for (;;) {
        const bool has_next = S.next(ui + 1, nxt);
        const char* nA = has_next ? PG8_AOF(nxt) : cA; const char* nB = has_next ? PG8_BOF(nxt) : cB;
        for (int t = 0; t < nt; t += 2) {
            const bool last = (t == nt - 2);
            const char* a1 = cA + (size_t)(t + 1) * kstep;
            const char* a2 = last ? nA : cA + (size_t)(t + 2) * kstep; const char* b2 = last ? nB : cB + (size_t)(t + 2) * kstep;
            const char* a3 = a2 + kstep; const char* b3 = b2 + kstep;
            if (last && has_next) S.a_ready(nxt);
            if constexpr (SP2) {
            PG8_LDB(B0, 0, 0); PG8_LDB(B1, 0, 1); PG8_SCHED; PG8_LDA(At, 0, 0); PG8_STAGE(PG8_SA(1, 1), a1 + hA, voffA);
            PG8_WAIT_V(8); PG8_WAIT_L(0); PG8_BAR; PG8_MMA(0, 0, At, B0); PG8_MMA(0, 1, At, B1); PG8_BAR; PG8_SCHED;
            PG8_LDA(At, 0, 1); PG8_STAGE(PG8_SB(0, 0), b2, voffB); PG8_STAGE(PG8_SB(0, 1), b2 + hB, voffB); PG8_STAGE(PG8_SA(0, 0), a2, voffA);
            PG8_WAIT_V(8); PG8_WAIT_L(0); PG8_BAR; PG8_MMA(1, 0, At, B0); PG8_MMA(1, 1, At, B1); PG8_BAR; PG8_SCHED;
            PG8_LDB(B0, 1, 0); PG8_LDB(B1, 1, 1); PG8_SCHED; PG8_LDA(At, 1, 0); PG8_STAGE(PG8_SA(0, 1), a2 + hA, voffA);
            PG8_WAIT_V(8); PG8_WAIT_L(0); PG8_BAR; PG8_MMA(0, 0, At, B0); PG8_MMA(0, 1, At, B1); PG8_BAR; PG8_SCHED;
            PG8_LDA(At, 1, 1); PG8_STAGE(PG8_SB(1, 0), b3, voffB); PG8_STAGE(PG8_SB(1, 1), b3 + hB, voffB); PG8_STAGE(PG8_SA(1, 0), a3, voffA);
            PG8_WAIT_V(8); PG8_WAIT_L(0); PG8_BAR; PG8_MMA(1, 0, At, B0); PG8_MMA(1, 1, At, B1); PG8_BAR; PG8_SCHED;
            } else {
            PG8_LDB(B0, 0, 0); PG8_SCHED; PG8_LDA(At, 0, 0); PG8_STAGE(PG8_SA(1, 1), a1 + hA, voffA);
            PG8_WAIT_L(8); PG8_BAR; PG8_WAIT_L(0); PG8_MMA(0, 0, At, B0); PG8_BAR; PG8_SCHED;
            PG8_LDB(B1, 0, 1); PG8_STAGE(PG8_SB(0, 0), b2, voffB);
            PG8_BAR; PG8_WAIT_L(0); PG8_MMA(0, 1, At, B1); PG8_BAR;
            PG8_LDA(At, 0, 1); PG8_STAGE(PG8_SA(0, 0), a2, voffA);
            PG8_BAR; PG8_WAIT_L(0); PG8_MMA(1, 0, At, B0); PG8_BAR; PG8_SCHED;
            PG8_STAGE(PG8_SB(0, 1), b2 + hB, voffB);
            PG8_WAIT_V(6); PG8_BAR; PG8_MMA(1, 1, At, B1); PG8_BAR;
            PG8_LDB(B0, 1, 0); PG8_SCHED; PG8_LDA(At, 1, 0); PG8_STAGE(PG8_SA(0, 1), a2 + hA, voffA);
            PG8_WAIT_L(8); PG8_BAR; PG8_WAIT_L(0); PG8_MMA(0, 0, At, B0); PG8_BAR; PG8_SCHED;
            PG8_LDB(B1, 1, 1); PG8_STAGE(PG8_SB(1, 0), b3, voffB);
            PG8_BAR; PG8_WAIT_L(0); PG8_MMA(0, 1, At, B1); PG8_BAR;
            PG8_LDA(At, 1, 1); PG8_STAGE(PG8_SA(1, 0), a3, voffA);
            PG8_BAR; PG8_WAIT_L(0); PG8_MMA(1, 0, At, B0); PG8_BAR; PG8_SCHED;
            PG8_STAGE(PG8_SB(1, 1), b3 + hB, voffB);
            PG8_WAIT_V(6); PG8_BAR; PG8_MMA(1, 1, At, B1); PG8_BAR;
            }
        }
        if constexpr (ALIGN_EPI) { if (wr == 0) PG8_BAR; }
        if constexpr (!Epi::AFTER_DRAIN) { E(acc, cur, wr, wc, fr, fq); S.done(cur); }
        if (!has_next) break;
#pragma unroll
        for (int a = 0; a < 2; ++a)
#pragma unroll
            for (int b = 0; b < 2; ++b)
#pragma unroll
                for (int m = 0; m < 4; ++m)
#pragma unroll
                    for (int n = 0; n < 2; ++n) acc[a][b][m][n] = (f32x4){0.f, 0.f, 0.f, 0.f};
        cur = nxt; cA = nA; cB = nB; ++ui;
        if constexpr (ALIGN_EPI) { if (wr == 1) PG8_BAR; }
    }
    PG8_WAIT_V(0);
    if constexpr (!ALIGN_EPI) { if (wr == 0) PG8_BAR; }
    PG8_BAR;
    if constexpr (Epi::AFTER_DRAIN) { E.fused(acc, cur, wr, wc, fr, fq, lds, wid, lane); S.done(cur); }
#undef PG8_SA
#undef PG8_AOF
#undef PG8_BOF
#undef PG8_SB
#undef PG8_STAGE
#undef PG8_LDA
#undef PG8_LDB
#undef PG8_MMA
#undef PG8_WAIT_V
#undef PG8_WAIT_L
#undef PG8_BAR
#undef PG8_SCHED
}
}
namespace pg8 {
typedef unsigned u32x2 __attribute__((ext_vector_type(2)));
__device__ __forceinline__ unsigned cvt_pk_bf16(float lo, float hi) { unsigned r; asm volatile("v_cvt_pk_bf16_f32 %0, %1, %2" : "=v"(r) : "v"(lo), "v"(hi)); return r; }
__device__ __forceinline__ float siluf(float x) { return x * __builtin_amdgcn_rcpf(1.f + __expf(-x)); }
struct EpiStore {
    static constexpr bool PERM = true, AFTER_DRAIN = false;
    bf16_t* O; int ldc; int silu_cols; float scale;
    __device__ __forceinline__ void operator()(const f32x4 (&acc)[2][2][4][2], const Unit& u, int wr, int wc, int fr, int fq) const {
        const int row0 = u.pm * BM + wr * 64 + fr, col0 = u.pn * BM + wc * 32 + 8 * fq;
        const bool act = (u.pn * BM) < silu_cols;
#pragma unroll
        for (int ai = 0; ai < 2; ++ai)
#pragma unroll
            for (int m = 0; m < 4; ++m) { bf16_t* rowp = O + (size_t)(row0 + ai * HALF + m * 16) * ldc + col0;
#pragma unroll
                for (int bj = 0; bj < 2; ++bj) { f32x4 v0 = acc[ai][bj][m][0], v1 = acc[ai][bj][m][1];
                    if (act) {
#pragma unroll
                        for (int e = 0; e < 4; ++e) { v0[e] = siluf(v0[e]); v1[e] = siluf(v1[e]); } }
                    v0 = v0 * scale; v1 = v1 * scale; u32x4 w; w.x = cvt_pk_bf16(v0[0], v0[1]); w.y = cvt_pk_bf16(v0[2], v0[3]); w.z = cvt_pk_bf16(v1[0], v1[1]); w.w = cvt_pk_bf16(v1[2], v1[3]);
                    *(u32x4*)(rowp + bj * HALF) = w; } }
    }
};
struct EpiSwiGLU {
    static constexpr bool PERM = true, AFTER_DRAIN = false;
    bf16_t* O; int ldc;
    __device__ __forceinline__ void operator()(const f32x4 (&acc)[2][2][4][2], const Unit& u, int wr, int wc, int fr, int fq) const {
        const int row0 = u.pm * BM + wr * 64 + fr, col0 = u.pn * HALF + wc * 32 + 8 * fq;
#pragma unroll
        for (int ai = 0; ai < 2; ++ai)
#pragma unroll
            for (int m = 0; m < 4; ++m) { bf16_t* rowp = O + (size_t)(row0 + ai * HALF + m * 16) * ldc + col0;
                f32x4 h0, h1;
#pragma unroll
                for (int e = 0; e < 4; ++e) { h0[e] = siluf(acc[ai][0][m][0][e]) * acc[ai][1][m][0][e]; h1[e] = siluf(acc[ai][0][m][1][e]) * acc[ai][1][m][1][e]; }
                u32x4 w; w.x = cvt_pk_bf16(h0[0], h0[1]); w.y = cvt_pk_bf16(h0[2], h0[3]); w.z = cvt_pk_bf16(h1[0], h1[1]); w.w = cvt_pk_bf16(h1[2], h1[3]);
                *(u32x4*)rowp = w; }
    }
};
struct EpiResid {
    static constexpr bool PERM = false, AFTER_DRAIN = false;
    const float* xin; float* z; float alpha;
    __device__ __forceinline__ void operator()(const f32x4 (&acc)[2][2][4][2], const Unit& u, int wr, int wc, int fr, int fq) const {
        const int col0 = u.pn * BM + wc * 32 + 4 * fq;
#pragma unroll
        for (int ai = 0; ai < 2; ++ai)
#pragma unroll
            for (int m = 0; m < 4; ++m) { const size_t off = (size_t)(u.pm * BM + ai * HALF + wr * 64 + m * 16 + fr) * 1024 + col0;
#pragma unroll
                for (int bj = 0; bj < 2; ++bj)
#pragma unroll
                    for (int n = 0; n < 2; ++n) { const f32x4 xv = *(const f32x4*)(xin + off + bj * HALF + n * 16); *(f32x4*)(z + off + bj * HALF + n * 16) = xv * alpha + acc[ai][bj][m][n]; } }
    }
};
struct EpiSoftmax {
    static constexpr bool PERM = false, AFTER_DRAIN = true;
    bf16_t* P;
    __device__ __forceinline__ void fused(f32x4 (&acc)[2][2][4][2], const Unit& u, int wr, int wc, int fr, int fq, PG8_LAS unsigned char* lds, int wid, int lane) const {
        typedef float f32x2v __attribute__((ext_vector_type(2)));
        PG8_LAS f32x2v* X = (PG8_LAS f32x2v*)lds;
        float mxl[2][4];
#pragma unroll
        for (int ai = 0; ai < 2; ++ai)
#pragma unroll
            for (int m = 0; m < 4; ++m) {
                float mx = -3.0e38f;
#pragma unroll
                for (int bj = 0; bj < 2; ++bj)
#pragma unroll
                    for (int n = 0; n < 2; ++n) { const f32x4 x = acc[ai][bj][m][n]; mx = fmaxf(mx, fmaxf(fmaxf(x[0], x[1]), fmaxf(x[2], x[3]))); }
                mx = fmaxf(mx, __shfl_xor(mx, 16)); mx = fmaxf(mx, __shfl_xor(mx, 32));
                float s = 0.f;
#pragma unroll
                for (int bj = 0; bj < 2; ++bj)
#pragma unroll
                    for (int n = 0; n < 2; ++n) { f32x4 x = acc[ai][bj][m][n];
#pragma unroll
                        for (int e = 0; e < 4; ++e) { x[e] = __builtin_amdgcn_exp2f(x[e] - mx); s += x[e]; }
                        acc[ai][bj][m][n] = x; }
                s += __shfl_xor(s, 16); s += __shfl_xor(s, 32);
                mxl[ai][m] = mx;
                if (fq == 0) X[(ai * HALF + wr * 64 + m * 16 + fr) * 4 + wc] = (f32x2v){mx, s};
            }
        asm volatile("s_waitcnt lgkmcnt(0)" ::: "memory"); __builtin_amdgcn_s_barrier(); asm volatile("" ::: "memory");
        const int col0 = u.pn * BM + wc * 32 + 4 * fq;
#pragma unroll
        for (int ai = 0; ai < 2; ++ai)
#pragma unroll
            for (int m = 0; m < 4; ++m) { const int r = ai * HALF + wr * 64 + m * 16 + fr;
                const f32x2v a = X[r * 4 + 0], b = X[r * 4 + 1], c = X[r * 4 + 2], d = X[r * 4 + 3];
                const float gm = fmaxf(fmaxf(a.x, b.x), fmaxf(c.x, d.x));
                const float S = a.y * __builtin_amdgcn_exp2f(a.x - gm) + b.y * __builtin_amdgcn_exp2f(b.x - gm) + c.y * __builtin_amdgcn_exp2f(c.x - gm) + d.y * __builtin_amdgcn_exp2f(d.x - gm);
                const float f = __builtin_amdgcn_exp2f(mxl[ai][m] - gm) / S;
                bf16_t* rowp = P + (size_t)(u.pm * BM + r) * 1024 + col0;
#pragma unroll
                for (int bj = 0; bj < 2; ++bj)
#pragma unroll
                    for (int n = 0; n < 2; ++n) { const f32x4 x = acc[ai][bj][m][n] * f; u32x2 w; w.x = cvt_pk_bf16(x[0], x[1]); w.y = cvt_pk_bf16(x[2], x[3]); *(u32x2*)(rowp + bj * HALF + n * 16) = w; } }
        asm volatile("s_waitcnt lgkmcnt(0)" ::: "memory"); __builtin_amdgcn_s_barrier(); asm volatile("" ::: "memory");
    }
};
}
#define LAS __attribute__((address_space(3)))
typedef unsigned short bf16_t;
typedef short bf16x8 __attribute__((ext_vector_type(8)));
typedef short s16x4 __attribute__((ext_vector_type(4)));
typedef float f32x2 __attribute__((ext_vector_type(2)));
typedef float f32x4 __attribute__((ext_vector_type(4)));
typedef float f32x16 __attribute__((ext_vector_type(16)));
typedef unsigned u32x2 __attribute__((ext_vector_type(2)));
typedef unsigned u32x4 __attribute__((ext_vector_type(4)));
constexpr int M = 16384, DM = 1024, NMEM = 256, DFF = 2816;
constexpr float ALPHA = 1.6817928305074290f, LN_EPS = 1e-6f;
constexpr int LDS_BYTES = 147456;
constexpr size_t MiB = 1u << 20;
constexpr size_t O_CTL = 0;
constexpr size_t O_WAB = 1 * MiB;
constexpr size_t O_WOAB = O_WAB + 2ull * 3072 * 1024 * 2;
constexpr size_t O_WCD = O_WOAB + 2ull * 1024 * 1024 * 2;
constexpr size_t O_WOCD = O_WCD + 2ull * 2048 * 1024 * 2;
constexpr size_t O_WQ = O_WOCD + 2ull * 1024 * 1024 * 2;
constexpr size_t O_WKV = O_WQ + 4ull * 1024 * 1024 * 2;
constexpr size_t O_WO = O_WKV + 4ull * 2048 * 1024 * 2;
constexpr size_t O_WGU = O_WO + 4ull * 1024 * 1024 * 2;
constexpr size_t O_WDN = O_WGU + 4ull * 5632 * 1024 * 2;
constexpr size_t O_MEMB = O_WDN + 4ull * 1024 * 2816 * 2;
constexpr size_t O_XK = O_MEMB + 256ull * 1024 * 2;
constexpr size_t O_XVT = O_XK + 4ull * 256 * 1024 * 2;
constexpr size_t O_H = O_XVT + 4ull * 1024 * 256 * 2;
constexpr size_t O_CAT = O_H + (size_t)M * 3072 * 2;
constexpr size_t O_XN = O_CAT + (size_t)M * 1024 * 2;
constexpr size_t O_OF = O_XN + (size_t)M * 1024 * 2;
constexpr size_t O_ST = O_OF + (size_t)M * 512 * 4;
constexpr size_t O_END = O_ST + 8ull * 32 * 16384 * 4;

__device__ __forceinline__ float bf2f(unsigned h) { return __uint_as_float(h << 16); }
__device__ __forceinline__ unsigned pk2(float lo, float hi) { return pg8::cvt_pk_bf16(lo, hi); }
__device__ __forceinline__ float wave_sum(float v) {
#pragma unroll
    for (int o = 1; o < 64; o <<= 1) v += __shfl_xor(v, o);
    return v;
}
#define LDS_WAIT() asm volatile("s_waitcnt lgkmcnt(0)" ::: "memory")

__device__ __forceinline__ void tr_item(const float* W, int N, bf16_t* WT, int ldo, int orow0, LAS float* scr, int k0, int n0, int lane) {
#pragma unroll 8
    for (int i = 0; i < 32; ++i) { const int kk = 2 * i + (lane >> 5); scr[kk * 33 + (lane & 31)] = W[(size_t)(k0 + kk) * N + n0 + (lane & 31)]; }
    LDS_WAIT(); asm volatile("" ::: "memory");
    const int c = lane & 7;
#pragma unroll
    for (int j = 0; j < 4; ++j) { const int n = (lane >> 3) + 8 * j; const LAS float* s = scr + (8 * c) * 33 + n;
        u32x4 o; o.x = pk2(s[0 * 33], s[1 * 33]); o.y = pk2(s[2 * 33], s[3 * 33]); o.z = pk2(s[4 * 33], s[5 * 33]); o.w = pk2(s[6 * 33], s[7 * 33]);
        *(u32x4*)(WT + (size_t)(orow0 + n) * ldo + k0 + 8 * c) = o; }
    LDS_WAIT(); asm volatile("" ::: "memory");
}
struct Args { const float* in[23]; float* out; unsigned char* ws; };
typedef const __attribute__((address_space(4))) Args* KArgP;

__device__ __forceinline__ void prologue(KArgP ap, LAS unsigned char* lds, int G) {
    const float* const* in = (const float* const*)0; (void)in;
#define a (*ap)
    const int tid = otid(), lane = tid & 63, wave = __builtin_amdgcn_readfirstlane(tid >> 6);
    LAS float* scr = (LAS float*)(lds + wave * 16384);
    const int gw = blockIdx.x * 8 + wave, NGW = G * 8;
    unsigned char* ws = a.ws;
    constexpr int I_AB = 16 * 96, I_OAB = 8 * 32, I_CD = 16 * 64, I_OCD = 16 * 32, I_Q = 16 * 32, I_KV = 16 * 64, I_O = 16 * 32, I_GU = 16 * 176, I_DN = 44 * 32;
    constexpr int NITEMS = 2 * I_AB + 2 * I_OAB + 2 * I_CD + 2 * I_OCD + 4 * I_Q + 4 * I_KV + 4 * I_O + 4 * I_GU + 4 * I_DN;
    for (int it = gw; it < NITEMS; it += NGW) {
        int r = it;
        if (r < 2 * I_AB) { const int j = r / I_AB, q = r % I_AB, kb = q / 96, nb = q % 96;
            tr_item(a.in[2] + (size_t)j * 1024 * 3072, 3072, (bf16_t*)(ws + O_WAB) + (size_t)j * 3072 * 1024, 1024, 32 * nb, scr, 64 * kb, 32 * nb, lane); continue; } r -= 2 * I_AB;
        if (r < 2 * I_OAB) { const int j = r / I_OAB, q = r % I_OAB, kb = q / 32, nb = q % 32;
            tr_item(a.in[7] + (size_t)j * 1024 * 1024, 1024, (bf16_t*)(ws + O_WOAB) + (size_t)j * 1024 * 1024, 1024, 32 * nb, scr, 64 * kb, 32 * nb, lane); continue; } r -= 2 * I_OAB;
        if (r < 2 * I_CD) { const int j = r / I_CD, q = r % I_CD, kb = q / 64, nb = q % 64;
            tr_item(a.in[8] + (size_t)j * 1024 * 2048, 2048, (bf16_t*)(ws + O_WCD) + (size_t)j * 2048 * 1024, 1024, 32 * nb, scr, 64 * kb, 32 * nb, lane); continue; } r -= 2 * I_CD;
        if (r < 2 * I_OCD) { const int j = r / I_OCD, q = r % I_OCD, kb = q / 32, nb = q % 32;
            tr_item(a.in[15] + (size_t)j * 1024 * 1024, 1024, (bf16_t*)(ws + O_WOCD) + (size_t)j * 1024 * 1024, 1024, 32 * nb, scr, 64 * kb, 32 * nb, lane); continue; } r -= 2 * I_OCD;
        if (r < 4 * I_Q) { const int j = r / I_Q, q = r % I_Q, kb = q / 32, nb = q % 32;
            tr_item(a.in[16] + (size_t)j * 1024 * 1024, 1024, (bf16_t*)(ws + O_WQ) + (size_t)j * 1024 * 1024, 1024, 32 * nb, scr, 64 * kb, 32 * nb, lane); continue; } r -= 4 * I_Q;
        if (r < 4 * I_KV) { const int j = r / I_KV, q = r % I_KV, kb = q / 64, nb = q % 64;
            tr_item(a.in[17] + (size_t)j * 1024 * 2048, 2048, (bf16_t*)(ws + O_WKV) + (size_t)j * 2048 * 1024, 1024, 32 * nb, scr, 64 * kb, 32 * nb, lane); continue; } r -= 4 * I_KV;
        if (r < 4 * I_O) { const int j = r / I_O, q = r % I_O, kb = q / 32, nb = q % 32;
            tr_item(a.in[18] + (size_t)j * 1024 * 1024, 1024, (bf16_t*)(ws + O_WO) + (size_t)j * 1024 * 1024, 1024, 32 * nb, scr, 64 * kb, 32 * nb, lane); continue; } r -= 4 * I_O;
        if (r < 4 * I_GU) { const int j = r / I_GU, q = r % I_GU, kb = q / 176, nb = q % 176; const int n0 = 32 * nb;
            const int orow0 = n0 < DFF ? (n0 / 128) * 256 + (n0 % 128) : ((n0 - DFF) / 128) * 256 + 128 + ((n0 - DFF) % 128);
            tr_item(a.in[19] + (size_t)j * 1024 * 5632, 5632, (bf16_t*)(ws + O_WGU) + (size_t)j * 5632 * 1024, 1024, orow0, scr, 64 * kb, n0, lane); continue; } r -= 4 * I_GU;
        { const int j = r / I_DN, q = r % I_DN, kb = q / 32, nb = q % 32;
            tr_item(a.in[20] + (size_t)j * 2816 * 1024, 1024, (bf16_t*)(ws + O_WDN) + (size_t)j * 1024 * 2816, 2816, 32 * nb, scr, 64 * kb, 32 * nb, lane); }
    }
    for (int it = gw; it < 2048; it += NGW) {
        const int db = it & 15, cgp = (it >> 4) & 15, g = (it >> 8) & 3, j = it >> 10, n = db * 64 + lane, c0 = cgp * 8;
        const float* wo = a.in[7] + (size_t)j * 1024 * 1024 + (size_t)(512 + g * 128) * 1024 + n;
        const float* ps = a.in[6] + j * 512 + g * 128;
        const float* pw = a.in[5] + ((size_t)(j * 4 + g) * 128 + c0) * 128;
        float acc[8];
#pragma unroll
        for (int ci = 0; ci < 8; ++ci) acc[ci] = 0.f;
        for (int e = 0; e < 128; ++e) { const float w = wo[(size_t)e * 1024] * ps[e];
#pragma unroll
            for (int ci = 0; ci < 8; ++ci) acc[ci] += pw[ci * 128 + e] * w; }
        u32x4 o; o.x = pk2(acc[0], acc[1]); o.y = pk2(acc[2], acc[3]); o.z = pk2(acc[4], acc[5]); o.w = pk2(acc[6], acc[7]);
        *(u32x4*)((bf16_t*)(ws + O_WOAB) + (size_t)j * 1024 * 1024 + (size_t)n * 1024 + 512 + g * 128 + c0) = o;
    }
    const int gt = blockIdx.x * 512 + tid, GT = G * 512;
    for (int i = gt; i < NMEM * DM / 8; i += GT) { const f32x4 p = ((const f32x4*)a.in[1])[2 * i], q = ((const f32x4*)a.in[1])[2 * i + 1];
        u32x4 o; o.x = pk2(p[0], p[1]); o.y = pk2(p[2], p[3]); o.z = pk2(q[0], q[1]); o.w = pk2(q[2], q[3]); ((u32x4*)(ws + O_MEMB))[i] = o; }
    for (int i = gt; i < M * DM / 8; i += GT) { const f32x4 p = ((const f32x4*)a.in[0])[2 * i], q = ((const f32x4*)a.in[0])[2 * i + 1];
        u32x4 o; o.x = pk2(p[0], p[1]); o.y = pk2(p[2], p[3]); o.z = pk2(q[0], q[1]); o.w = pk2(q[2], q[3]); ((u32x4*)(ws + O_XN))[i] = o; }
    if (blockIdx.x == 0) {
        for (int i = tid; i < 1024; i += 512) { const int dir = i >> 9, c = i & 511; const float* lg = a.in[3] + (size_t)dir * 4 * 512 + c;
            const float l0 = lg[0], l1 = lg[512], l2 = lg[1024], l3 = lg[1536]; const float mx = fmaxf(fmaxf(l0, l1), fmaxf(l2, l3));
            const float e0 = expf(l0 - mx), e1 = expf(l1 - mx), e2 = expf(l2 - mx), e3 = expf(l3 - mx), inv = 1.f / (e0 + e1 + e2 + e3);
            float* lb = (float*)(ws + O_CTL) + (size_t)dir * 4 * 512 + c;
            lb[0] = 0.f; lb[512] = fmaxf(e1 * inv, 0.f); lb[1024] = fmaxf((e1 + e2) * inv, 0.f); lb[1536] = fmaxf((e1 + e2 + e3) * inv, 0.f); }
    }
#undef a
}

__device__ __forceinline__ void ln_phase(float* Z, bf16_t* XN, const float* gam, const float* bet, int G) {
    const int tid = otid(), lane = tid & 63, wave = tid >> 6;
    const int gw = blockIdx.x * 8 + wave, NGW = G * 8;
    f32x4 gv[4], bv[4];
#pragma unroll
    for (int j = 0; j < 4; ++j) { gv[j] = ((const f32x4*)gam)[lane + 64 * j]; bv[j] = ((const f32x4*)bet)[lane + 64 * j]; }
    for (int m = gw; m < M; m += NGW) {
        f32x4* zr = (f32x4*)(Z + (size_t)m * DM) + lane;
        f32x4 v[4]; float s = 0.f;
#pragma unroll
        for (int j = 0; j < 4; ++j) { v[j] = zr[64 * j]; s += (v[j][0] + v[j][1]) + (v[j][2] + v[j][3]); }
        const float mean = wave_sum(s) * (1.f / DM); float s2 = 0.f;
#pragma unroll
        for (int j = 0; j < 4; ++j) { v[j] = v[j] - mean; s2 += (v[j][0] * v[j][0] + v[j][1] * v[j][1]) + (v[j][2] * v[j][2] + v[j][3] * v[j][3]); }
        const float rstd = 1.f / sqrtf(wave_sum(s2) * (1.f / DM) + LN_EPS);
        u32x2* o8 = (u32x2*)(XN + (size_t)m * DM) + lane;
#pragma unroll
        for (int j = 0; j < 4; ++j) { const f32x4 y = v[j] * rstd * gv[j] + bv[j]; zr[64 * j] = y; u32x2 w; w.x = pk2(y[0], y[1]); w.y = pk2(y[2], y[3]); o8[64 * j] = w; }
    }
}
constexpr int HO_QT = 0, HO_KT = HO_QT + 64 * 136 * 2, HO_QH = HO_KT + 64 * 136 * 2, HO_KTT = HO_QH + 64 * 136 * 2, HO_VT = HO_KTT + 128 * 72 * 2,
              HO_ST = HO_VT + 128 * 72 * 2, HO_PM = HO_ST + 128 * 136 * 2, HO_DV = HO_PM + 64 * 72 * 2, HO_TOT = HO_DV + 512, HO_END = HO_TOT + 8 * 128 * 4;
static_assert(HO_END <= LDS_BYTES, "hgrn lds");
__device__ __forceinline__ int crow(int r, int hi) { return (r & 3) + 8 * (r >> 2) + 4 * hi; }
#define MFMA32(a, b, c) __builtin_amdgcn_mfma_f32_32x32x16_bf16((a), (b), (c), 0, 0, 0)
#define WG_BAR() do { asm volatile("s_waitcnt vmcnt(0) lgkmcnt(0)" ::: "memory"); __builtin_amdgcn_s_barrier(); asm volatile("" ::: "memory"); } while (0)

template <bool OUT>
__device__ __forceinline__ void hgrn_item(LAS unsigned char* lds, const bf16_t* H, const float* lbtab, int layer, int dir, int head, int seg, float* Ust, float* Dseg, float* Odir) {
    const int tid = otid(), w = __builtin_amdgcn_readfirstlane(tid >> 6), lane = tid & 63, l32 = lane & 31, hi = lane >> 5;
    const int chain = dir * 4 + head, c0 = head * 128 + 2 * lane;
    const float lb0 = lbtab[(dir * 4 + layer) * 512 + c0], lb1 = lbtab[(dir * 4 + layer) * 512 + c0 + 1];
    const int ki = w >> 1, vi0 = 2 * (w & 1);
    LAS float* dvec = (LAS float*)(lds + HO_DV); LAS float* tot = (LAS float*)(lds + HO_TOT);
    float* Sg = Ust + ((size_t)(chain * 32 + seg)) * 16384;
    f32x16 S0, S1;
#pragma unroll
    for (int r = 0; r < 16; ++r) { S0[r] = 0.f; S1[r] = 0.f; }
    if (OUT) {
#pragma unroll
        for (int r = 0; r < 16; ++r) { const int k = 32 * ki + crow(r, hi); S0[r] = Sg[k * 128 + 32 * vi0 + l32]; S1[r] = Sg[k * 128 + 32 * (vi0 + 1) + l32]; }
#pragma unroll
        for (int q4 = 0; q4 < 4; ++q4) { const int k = 32 * ki + 8 * q4 + 4 * hi;
            u32x2 a; a.x = pk2(S0[4 * q4], S0[4 * q4 + 1]); a.y = pk2(S0[4 * q4 + 2], S0[4 * q4 + 3]); *(LAS u32x2*)(lds + HO_ST + (32 * vi0 + l32) * 272 + k * 2) = a;
            u32x2 b; b.x = pk2(S1[4 * q4], S1[4 * q4 + 1]); b.y = pk2(S1[4 * q4 + 2], S1[4 * q4 + 3]); *(LAS u32x2*)(lds + HO_ST + (32 * (vi0 + 1) + l32) * 272 + k * 2) = b; }
    }
    float run0 = 0.f, run1 = 0.f;
    const int zoff = dir ? 1536 : 1024;
    for (int c = 0; c < 8; ++c) {
        const int tau0 = seg * 512 + c * 64 + 8 * w;
        float q0[8], q1[8], v0[8], v1[8], k0[8], k1[8], b0[8], b1[8];
#pragma unroll
        for (int i = 0; i < 8; ++i) { const int tau = tau0 + i, t = dir ? (M - 1 - tau) : tau; const bf16_t* row = H + (size_t)t * 3072 + c0;
            const unsigned qq = *(const unsigned*)row, vv = *(const unsigned*)(row + 512), zz = *(const unsigned*)(row + zoff);
            q0[i] = bf2f(qq & 0xffffu); q1[i] = bf2f(qq >> 16); v0[i] = bf2f(vv & 0xffffu); v1[i] = bf2f(vv >> 16);
            const float z0 = fmaxf(bf2f(zz & 0xffffu), -30.f), z1 = fmaxf(bf2f(zz >> 16), -30.f);
            const float e0 = __expf(-z0), e1 = __expf(-z1), s0 = 1.f / (1.f + e0), s1 = 1.f / (1.f + e1);
            k0[i] = (1.f - lb0) * e0 * s0; k1[i] = (1.f - lb1) * e1 * s1;
            const float g0 = __logf(lb0 + (1.f - lb0) * s0), g1 = __logf(lb1 + (1.f - lb1) * s1);
            b0[i] = (i ? b0[i - 1] : 0.f) + g0; b1[i] = (i ? b1[i - 1] : 0.f) + g1; }
        *(LAS f32x2*)(tot + w * 128 + 2 * lane) = (f32x2){b0[7], b1[7]};
        WG_BAR();
        float pre0 = 0.f, pre1 = 0.f, tt0 = 0.f, tt1 = 0.f;
#pragma unroll
        for (int ww = 0; ww < 8; ++ww) { const f32x2 x = *(LAS f32x2*)(tot + ww * 128 + 2 * lane); tt0 += x[0]; tt1 += x[1]; if (ww < w) { pre0 += x[0]; pre1 += x[1]; } }
        const float r0 = 0.5f * tt0, r1 = 0.5f * tt1, d0 = __expf(r0), d1 = __expf(r1);
        run0 += tt0; run1 += tt1;
        {
            unsigned ktw0[4], ktw1[4], vtw0[4], vtw1[4]; float kp0 = 0.f, kp1 = 0.f;
#pragma unroll
            for (int i = 0; i < 8; ++i) { const float bb0 = pre0 + b0[i], bb1 = pre1 + b1[i];
                const float eq0 = __expf(bb0 - r0), eq1 = __expf(bb1 - r1), ek0 = __expf(r0 - bb0), ek1 = __expf(r1 - bb1);
                const int ro = (8 * w + i) * 272 + lane * 4;
                if (OUT) { *(LAS unsigned*)(lds + HO_QT + ro) = pk2(q0[i] * eq0, q1[i] * eq1); *(LAS unsigned*)(lds + HO_KT + ro) = pk2(k0[i] * ek0, k1[i] * ek1);
                           *(LAS unsigned*)(lds + HO_QH + ro) = pk2(q0[i] * eq0 * d0, q1[i] * eq1 * d1); }
                const float kt0 = k0[i] * ek0 * d0, kt1 = k1[i] * ek1 * d1;
                if (i & 1) { ktw0[i >> 1] = pk2(kp0, kt0); ktw1[i >> 1] = pk2(kp1, kt1); vtw0[i >> 1] = pk2(v0[i - 1], v0[i]); vtw1[i >> 1] = pk2(v1[i - 1], v1[i]); }
                else { kp0 = kt0; kp1 = kt1; } }
            *(LAS u32x4*)(lds + HO_KTT + (2 * lane) * 144 + 16 * w) = (u32x4){ktw0[0], ktw0[1], ktw0[2], ktw0[3]};
            *(LAS u32x4*)(lds + HO_KTT + (2 * lane + 1) * 144 + 16 * w) = (u32x4){ktw1[0], ktw1[1], ktw1[2], ktw1[3]};
            *(LAS u32x4*)(lds + HO_VT + (2 * lane) * 144 + 16 * w) = (u32x4){vtw0[0], vtw0[1], vtw0[2], vtw0[3]};
            *(LAS u32x4*)(lds + HO_VT + (2 * lane + 1) * 144 + 16 * w) = (u32x4){vtw1[0], vtw1[1], vtw1[2], vtw1[3]};
        }
        if (w == 0) *(LAS f32x2*)(dvec + 2 * lane) = (f32x2){d0 * d0, d1 * d1};
        WG_BAR();
        f32x16 oacc;
        if (OUT) {
            if (w < 4) {
                const int ti = (w == 0 || w == 3) ? 0 : 1, si = (w >= 2) ? 1 : 0;
                f32x16 p;
#pragma unroll
                for (int r = 0; r < 16; ++r) p[r] = 0.f;
                if (w < 3) {
#pragma unroll
                    for (int kk = 0; kk < 8; ++kk) { const bf16x8 ka = *(LAS bf16x8*)(lds + HO_KT + (32 * si + l32) * 272 + kk * 32 + hi * 16), qb = *(LAS bf16x8*)(lds + HO_QT + (32 * ti + l32) * 272 + kk * 32 + hi * 16);
                        p = MFMA32(ka, qb, p); }
                }
                const int t = 32 * ti + l32;
#pragma unroll
                for (int q4 = 0; q4 < 4; ++q4) { const int s = 32 * si + 8 * q4 + 4 * hi; float x[4];
#pragma unroll
                    for (int e = 0; e < 4; ++e) x[e] = (s + e <= t) ? p[4 * q4 + e] : 0.f;
                    u32x2 o; o.x = pk2(x[0], x[1]); o.y = pk2(x[2], x[3]); *(LAS u32x2*)(lds + HO_PM + t * 144 + s * 2) = o; }
            }
            const int ti = w >> 2, vi = w & 3;
#pragma unroll
            for (int r = 0; r < 16; ++r) oacc[r] = 0.f;
#pragma unroll
            for (int kk = 0; kk < 8; ++kk) { const bf16x8 qa = *(LAS bf16x8*)(lds + HO_QH + (32 * ti + l32) * 272 + kk * 32 + hi * 16), sb = *(LAS bf16x8*)(lds + HO_ST + (32 * vi + l32) * 272 + kk * 32 + hi * 16);
                oacc = MFMA32(qa, sb, oacc); }
        }
#pragma unroll
        for (int q4 = 0; q4 < 4; ++q4) { const f32x4 dv = *(LAS f32x4*)(dvec + 32 * ki + 8 * q4 + 4 * hi);
#pragma unroll
            for (int e = 0; e < 4; ++e) { S0[4 * q4 + e] *= dv[e]; S1[4 * q4 + e] *= dv[e]; } }
#pragma unroll
        for (int kk = 0; kk < 4; ++kk) { const bf16x8 ka = *(LAS bf16x8*)(lds + HO_KTT + (32 * ki + l32) * 144 + kk * 32 + hi * 16);
            const bf16x8 vb0 = *(LAS bf16x8*)(lds + HO_VT + (32 * vi0 + l32) * 144 + kk * 32 + hi * 16), vb1 = *(LAS bf16x8*)(lds + HO_VT + (32 * (vi0 + 1) + l32) * 144 + kk * 32 + hi * 16);
            S0 = MFMA32(ka, vb0, S0); S1 = MFMA32(ka, vb1, S1); }
        WG_BAR();
        if (OUT) {
            const int ti = w >> 2, vi = w & 3;
#pragma unroll
            for (int kk = 0; kk < 4; ++kk) { const bf16x8 pa = *(LAS bf16x8*)(lds + HO_PM + (32 * ti + l32) * 144 + kk * 32 + hi * 16), vb = *(LAS bf16x8*)(lds + HO_VT + (32 * vi + l32) * 144 + kk * 32 + hi * 16);
                oacc = MFMA32(pa, vb, oacc); }
#pragma unroll
            for (int r = 0; r < 16; ++r) { const int tau = seg * 512 + c * 64 + 32 * ti + crow(r, hi), t = dir ? (M - 1 - tau) : tau;
                Odir[(size_t)t * 512 + head * 128 + 32 * vi + l32] = oacc[r]; }
#pragma unroll
            for (int q4 = 0; q4 < 4; ++q4) { const int k = 32 * ki + 8 * q4 + 4 * hi;
                u32x2 a; a.x = pk2(S0[4 * q4], S0[4 * q4 + 1]); a.y = pk2(S0[4 * q4 + 2], S0[4 * q4 + 3]); *(LAS u32x2*)(lds + HO_ST + (32 * vi0 + l32) * 272 + k * 2) = a;
                u32x2 b; b.x = pk2(S1[4 * q4], S1[4 * q4 + 1]); b.y = pk2(S1[4 * q4 + 2], S1[4 * q4 + 3]); *(LAS u32x2*)(lds + HO_ST + (32 * (vi0 + 1) + l32) * 272 + k * 2) = b; }
        }
    }
    if (!OUT) {
#pragma unroll
        for (int r = 0; r < 16; ++r) { const int k = 32 * ki + crow(r, hi); Sg[k * 128 + 32 * vi0 + l32] = S0[r]; Sg[k * 128 + 32 * (vi0 + 1) + l32] = S1[r]; }
        if (w == 0) *(f32x2*)(Dseg + (size_t)(chain * 32 + seg) * 128 + 2 * lane) = (f32x2){__expf(run0), __expf(run1)};
    }
    WG_BAR();
}
__device__ __forceinline__ void hgrn_scan(float* Ust, const float* Dseg, int G) {
    for (int e = blockIdx.x * 512 + threadIdx.x; e < 8 * 16384; e += G * 512) {
        const int chain = e >> 14, el = e & 16383, k = el >> 7; float r = 0.f;
        for (int s = 0; s < 32; ++s) { float* p = Ust + (size_t)(chain * 32 + s) * 16384 + el; const float u = *p; *p = r; r = Dseg[(chain * 32 + s) * 128 + k] * r + u; }
    }
}
__device__ __forceinline__ void hcomb_pool(const bf16_t* H, const float* Of, const float* Ob, const float* ng, bf16_t* CAT, int G) {
    const int tid = otid(), lane = tid & 63, wave = tid >> 6;
    const int gw = blockIdx.x * 8 + wave, NGW = G * 8;
    f32x4 g0 = ((const f32x4*)ng)[2 * lane], g1 = ((const f32x4*)ng)[2 * lane + 1];
    const int grp = lane >> 4, wdw = 2 << grp;
    for (int t = gw; t < M; t += NGW) {
        const f32x4 a0 = ((const f32x4*)(Of + (size_t)t * 512))[2 * lane], a1 = ((const f32x4*)(Of + (size_t)t * 512))[2 * lane + 1];
        const f32x4 c0 = ((const f32x4*)(Ob + (size_t)t * 512))[2 * lane], c1 = ((const f32x4*)(Ob + (size_t)t * 512))[2 * lane + 1];
        const f32x4 o0 = a0 + c0, o1 = a1 + c1;
        float ss = (o0[0] * o0[0] + o0[1] * o0[1]) + (o0[2] * o0[2] + o0[3] * o0[3]) + (o1[0] * o1[0] + o1[1] * o1[1]) + (o1[2] * o1[2] + o1[3] * o1[3]);
        ss += __shfl_xor(ss, 1); ss += __shfl_xor(ss, 2); ss += __shfl_xor(ss, 4); ss += __shfl_xor(ss, 8);
        const float rs = 1.f / sqrtf(ss * (1.f / 128.f) + LN_EPS);
        const u32x4 og = *(const u32x4*)(H + (size_t)t * 3072 + 2048 + 8 * lane);
        float y[8];
#pragma unroll
        for (int e = 0; e < 4; ++e) { y[e] = o0[e] * rs * g0[e]; y[4 + e] = o1[e] * rs * g1[e]; }
#pragma unroll
        for (int e = 0; e < 4; ++e) { const float glo = bf2f(og[e] & 0xffffu), ghi = bf2f(og[e] >> 16); y[2 * e] *= pg8::siluf(glo); y[2 * e + 1] *= pg8::siluf(ghi); }
        u32x4 o; o.x = pk2(y[0], y[1]); o.y = pk2(y[2], y[3]); o.z = pk2(y[4], y[5]); o.w = pk2(y[6], y[7]);
        *(u32x4*)(CAT + (size_t)t * 1024 + 8 * lane) = o;
        int lo = t - (wdw >> 1), hiw = lo + wdw - 1; lo = lo < 0 ? 0 : lo; hiw = hiw > M - 1 ? M - 1 : hiw;
        float sm[8];
#pragma unroll
        for (int e = 0; e < 8; ++e) sm[e] = 0.f;
        for (int tt = lo; tt <= hiw; ++tt) { const u32x4 uu = *(const u32x4*)(H + (size_t)tt * 3072 + 2560 + 8 * lane);
#pragma unroll
            for (int e = 0; e < 4; ++e) { sm[2 * e] += bf2f(uu[e] & 0xffffu); sm[2 * e + 1] += bf2f(uu[e] >> 16); } }
        const u32x4 ut = *(const u32x4*)(H + (size_t)t * 3072 + 2560 + 8 * lane); const float ic = 1.f / (float)(hiw - lo + 1);
        float dl[8];
#pragma unroll
        for (int e = 0; e < 4; ++e) { dl[2 * e] = sm[2 * e] * ic - bf2f(ut[e] & 0xffffu); dl[2 * e + 1] = sm[2 * e + 1] * ic - bf2f(ut[e] >> 16); }
        u32x4 o2; o2.x = pk2(dl[0], dl[1]); o2.y = pk2(dl[2], dl[3]); o2.z = pk2(dl[4], dl[5]); o2.w = pk2(dl[6], dl[7]);
        *(u32x4*)(CAT + (size_t)t * 1024 + 512 + 8 * lane) = o2;
    }
}
__device__ __forceinline__ void qk_prep(const bf16_t* H  , const float* qg, const float* kg, bf16_t* QP  , bf16_t* KP  , int G) {
    const int tid = otid(), lane = tid & 63, wave = tid >> 6;
    const int gw = blockIdx.x * 8 + wave, NGW = G * 8;
    const float fr = __builtin_amdgcn_exp2f(-(float)(lane & 31) * (13.287712379549449f / 32.f)) * 0.15915494309189535f;
    const float qg0 = qg[lane], qg1 = qg[64 + lane], kg0 = kg[lane], kg1 = kg[64 + lane];
    for (int t = gw; t < M; t += NGW) {
        const float ar = (float)(t >> 6) * fr, ac = (float)(t & 63) * fr;
        const float rr = ar - rintf(ar), rc = ac - rintf(ac);
        const float cr = __builtin_amdgcn_cosf(rr), sr = __builtin_amdgcn_sinf(rr), cc = __builtin_amdgcn_cosf(rc), sc = __builtin_amdgcn_sinf(rc);
        const bf16_t* row = H + (size_t)t * 2048;
#pragma unroll
        for (int hh = 0; hh < 6; ++hh) {
            const float x0 = bf2f(row[hh * 128 + lane]), x1 = bf2f(row[hh * 128 + 64 + lane]);
            const float ss = wave_sum(x0 * x0 + x1 * x1), rs = 1.f / sqrtf(ss * (1.f / 128.f) + LN_EPS);
            const float n0 = x0 * rs * (hh < 4 ? qg0 : kg0), n1 = x1 * rs * (hh < 4 ? qg1 : kg1);
            const float p0 = __shfl_xor(n0, 32), p1 = __shfl_xor(n1, 32);
            const float y0 = n0 * cr + (lane < 32 ? -p0 : p0) * sr, y1 = n1 * cc + (lane < 32 ? -p1 : p1) * sc;
            bf16_t* o = hh < 4 ? QP + (size_t)t * 512 + hh * 128 : KP + (size_t)t * 256 + (hh - 4) * 128;
            o[lane] = (bf16_t)(pk2(y0, 0.f) & 0xffffu); o[64 + lane] = (bf16_t)(pk2(y1, 0.f) & 0xffffu);
        }
    }
}
__device__ __forceinline__ void conv_items(LAS unsigned char* lds, const bf16_t* H, const float* cw, const float* cb, const float* lg, const float* lbv, bf16_t* CAT, int G) {
    const int c = otid(), lane = c & 63, wave = c >> 6;
    LAS float* part = (LAS float*)lds;
    float wt[31];
#pragma unroll
    for (int k = 0; k < 31; ++k) wt[k] = cw[k * 512 + c];
    const float bias = cb[c], gmm = lg[c], bta = lbv[c];
    for (int it = blockIdx.x; it < M / 16; it += G) {
        const int t0 = it * 16;
        float u[46];
#pragma unroll
        for (int r = 0; r < 46; ++r) { const int t = t0 - 15 + r; float x = 0.f;
            if (t >= 0 && t < M) { const float val = bf2f(H[(size_t)t * 2048 + 1024 + c]), gate = bf2f(H[(size_t)t * 2048 + 1536 + c]); x = val * __builtin_amdgcn_rcpf(1.f + __expf(-gate)); }
            u[r] = x; }
        float acc[16];
#pragma unroll
        for (int i = 0; i < 16; ++i) { float s = bias;
#pragma unroll
            for (int k = 0; k < 31; ++k) s += wt[k] * u[i + k];
            acc[i] = s; }
#pragma unroll
        for (int i = 0; i < 16; ++i) { const float s = wave_sum(acc[i]), s2 = wave_sum(acc[i] * acc[i]); if (lane == 0) *(LAS f32x2*)(part + (i * 8 + wave) * 2) = (f32x2){s, s2}; }
        WG_BAR();
#pragma unroll
        for (int i = 0; i < 16; ++i) { float s = 0.f, s2 = 0.f;
#pragma unroll
            for (int ww = 0; ww < 8; ww += 2) { const f32x4 p = *(LAS f32x4*)(part + (i * 8 + ww) * 2); s += p[0] + p[2]; s2 += p[1] + p[3]; }
            const float mean = s * (1.f / 512.f), var = fmaxf(s2 * (1.f / 512.f) - mean * mean, 0.f), rstd = 1.f / sqrtf(var + LN_EPS);
            const float y = (acc[i] - mean) * rstd * gmm + bta;
            CAT[(size_t)(t0 + i) * 1024 + 512 + c] = (bf16_t)(pk2(pg8::siluf(y), 0.f) & 0xffffu); }
        WG_BAR();
    }
}

namespace att {
constexpr int D = 128, NW = 8, QBLK = 32, KVBLK = 64;
constexpr float SCALE = 0.088388347648318440f, THR = 8.f;
constexpr int LDQ = 512, LDK = 256, LDV = 2048, LDO = 1024;
constexpr size_t SHM_V = KVBLK * D * 2, SHM_K = KVBLK * D * 2, SHM_ATTN = 2 * SHM_V + 2 * SHM_K + NW * 64 * 4;
#define KSWZ(row, colB) ((row) * 256 + ((colB) ^ (((row) & 7) << 4)))
#define SBAR() __builtin_amdgcn_sched_barrier(0)
__device__ __forceinline__ unsigned cvtpk(float lo, float hi) { unsigned r; asm volatile("v_cvt_pk_bf16_f32 %0, %1, %2" : "=v"(r) : "v"(lo), "v"(hi)); return r; }
__device__ __forceinline__ void partialSM(f32x16& p0, f32x16& p1, float& m_reg, float& mn, float& alpha) {
  constexpr float C = SCALE * 1.4426950408889634f;
  float pmax = p0[0]; for (int r = 1; r < 16; ++r) pmax = fmaxf(pmax, p0[r]); for (int r = 0; r < 16; ++r) pmax = fmaxf(pmax, p1[r]);
  { auto rr = __builtin_amdgcn_permlane32_swap(__float_as_uint(pmax), __float_as_uint(pmax), false, false);
    pmax = fmaxf(__uint_as_float(rr[0]), __uint_as_float(rr[1])); }
  if (__builtin_expect(__all(pmax - m_reg <= THR / SCALE), 1)) { mn = m_reg; alpha = 1.f; }
  else { mn = fmaxf(m_reg, pmax); alpha = __builtin_amdgcn_exp2f((m_reg - mn) * C); m_reg = mn; }
  float mnC = -mn * C;
  for (int r = 0; r < 16; ++r) p0[r] = fmaf(p0[r], C, mnC); for (int r = 0; r < 16; ++r) p1[r] = fmaf(p1[r], C, mnC);
  for (int r = 0; r < 16; ++r) p0[r] = __builtin_amdgcn_exp2f(p0[r]);
}
__device__ __forceinline__ void finishSM(f32x16& p0, f32x16& p1, float alpha, float& l_reg, bf16x8& pa0, bf16x8& pa1, bf16x8& pa2, bf16x8& pa3) {
  for (int r = 0; r < 16; ++r) p1[r] = __builtin_amdgcn_exp2f(p1[r]);
  float ps = 0; for (int r = 0; r < 16; ++r) ps += p0[r]; for (int r = 0; r < 16; ++r) ps += p1[r];
  { auto rr = __builtin_amdgcn_permlane32_swap(__float_as_uint(ps), __float_as_uint(ps), false, false);
    ps = __uint_as_float(rr[0]) + __uint_as_float(rr[1]); }
  l_reg = l_reg * alpha + ps;
#define PK4(P, BASE, OUT) do { unsigned a0 = cvtpk(P[BASE + 0], P[BASE + 1]), a1 = cvtpk(P[BASE + 2], P[BASE + 3]);   \
    unsigned b0 = cvtpk(P[BASE + 4], P[BASE + 5]), b1 = cvtpk(P[BASE + 6], P[BASE + 7]);                              \
    auto r0 = __builtin_amdgcn_permlane32_swap(a0, b0, false, false); auto r1 = __builtin_amdgcn_permlane32_swap(a1, b1, false, false); \
    u32x4 w = {r0[0], r1[0], r0[1], r1[1]}; OUT = *reinterpret_cast<bf16x8*>(&w); } while (0)
  PK4(p0, 0, pa0); PK4(p0, 8, pa1); PK4(p1, 0, pa2); PK4(p1, 8, pa3);
#undef PK4
}
__device__ __forceinline__ void qkt(f32x16& p0, f32x16& p1, const bf16_t* Ks, const bf16x8* qr, int r32, int hi) {
  p0 = f32x16{}; p1 = f32x16{};
  for (int d0 = 0; d0 < 8; ++d0) { int cb = (d0 * 16 + hi * 8) * 2;
    bf16x8 b0 = *reinterpret_cast<const bf16x8*>((const char*)Ks + KSWZ(r32, cb));
    bf16x8 b1 = *reinterpret_cast<const bf16x8*>((const char*)Ks + KSWZ(32 + r32, cb));
    p0 = __builtin_amdgcn_mfma_f32_32x32x16_bf16(b0, qr[d0], p0, 0, 0, 0);
    p1 = __builtin_amdgcn_mfma_f32_32x32x16_bf16(b1, qr[d0], p1, 0, 0, 0); }
}
__device__ __forceinline__ int v_st(int k, int c) { const int kk = (k & ~0xC) | ((k & 4) << 1) | ((k & 8) >> 1); return ((kk >> 3) * 4 + (c >> 5)) * 512 + ((kk & 7) * 32 + (c & 31)) * 2; }
__device__ __forceinline__ int v_rd_base(int lane) { return ((lane & 3) << 3) | (((lane >> 2) & 3) << 6) | (((lane >> 4) & 1) << 5) | (((lane >> 5) & 1) << 8); }
constexpr int v_rd_off(int d0, int ks, int half) { return d0 * 512 + ks * 4096 + half * 2048; }
template <int OFF> __device__ __forceinline__ s16x4 tr_read(int vb) {
  s16x4 r; asm volatile("ds_read_b64_tr_b16 %0, %1 offset:%2" : "=&v"(r) : "v"(vb), "i"(OFF) : "memory"); return r;
}
template <int D0> __device__ __forceinline__ void pv_one(f32x16& od, int vb, bf16x8 pa0, bf16x8 pa1, bf16x8 pa2, bf16x8 pa3) {
  const s16x4 l0 = tr_read<v_rd_off(D0, 0, 0)>(vb), h0 = tr_read<v_rd_off(D0, 0, 1)>(vb), l1 = tr_read<v_rd_off(D0, 1, 0)>(vb), h1 = tr_read<v_rd_off(D0, 1, 1)>(vb);
  const s16x4 l2 = tr_read<v_rd_off(D0, 2, 0)>(vb), h2 = tr_read<v_rd_off(D0, 2, 1)>(vb), l3 = tr_read<v_rd_off(D0, 3, 0)>(vb), h3 = tr_read<v_rd_off(D0, 3, 1)>(vb);
  asm volatile("s_waitcnt lgkmcnt(0)" ::: "memory"); SBAR();
#define PK(L, H) (bf16x8){L[0], L[1], L[2], L[3], H[0], H[1], H[2], H[3]}
  od = __builtin_amdgcn_mfma_f32_32x32x16_bf16(pa0, PK(l0, h0), od, 0, 0, 0);
  od = __builtin_amdgcn_mfma_f32_32x32x16_bf16(pa1, PK(l1, h1), od, 0, 0, 0);
  od = __builtin_amdgcn_mfma_f32_32x32x16_bf16(pa2, PK(l2, h2), od, 0, 0, 0);
  od = __builtin_amdgcn_mfma_f32_32x32x16_bf16(pa3, PK(l3, h3), od, 0, 0, 0);
#undef PK
}
__device__ __forceinline__ void pv_d0(f32x16* o, int vb, bf16x8 pa0, bf16x8 pa1, bf16x8 pa2, bf16x8 pa3) {
  pv_one<0>(o[0], vb, pa0, pa1, pa2, pa3); pv_one<1>(o[1], vb, pa0, pa1, pa2, pa3); pv_one<2>(o[2], vb, pa0, pa1, pa2, pa3); pv_one<3>(o[3], vb, pa0, pa1, pa2, pa3);
}
__device__ __forceinline__ void attn_dense_body(const bf16_t* __restrict__ Qb, const bf16_t* __restrict__ Kh, const bf16_t* __restrict__ Vh, bf16_t* __restrict__ Ob, int seq, char* lds) {
  const int tid = otid(), wid = tid >> 6, lane = tid & 63, r32 = lane & 31, hi = lane >> 5;
  bf16_t* V_lds = (bf16_t*)lds; bf16_t* K_lds = (bf16_t*)(lds + 2 * SHM_V);
  float* ws = (float*)(lds + 2 * SHM_V + 2 * SHM_K) + wid * 64; float* li_l = ws; float* al_l = ws + 32;
  float m_reg = -1e30f, l_reg = 0; f32x16 o[4] = {}; bf16x8 qr[8];
  const bf16_t* Qw = Qb + (long)(wid * QBLK + r32) * LDQ + hi * 8;
#pragma unroll
  for (int d0 = 0; d0 < 8; ++d0) qr[d0] = *reinterpret_cast<const bf16x8*>(Qw + d0 * 16);
  const int sr = tid >> 4, sc = (tid & 15) * 8, vst0 = v_st(sr, sc), vst1 = v_st(32 + sr, sc);
  const int vb0 = (int)(uintptr_t)V_lds + v_rd_base(lane);
  struct { bf16x8 vs0, vs1, ks0, ks1; } sr_[2];
#define LD8(p) (*reinterpret_cast<const bf16x8*>(p))
#define SLOAD(i, k0) do { sr_[i].vs0 = LD8(&Vh[(long)((k0) + sr) * LDV + sc]); sr_[i].vs1 = LD8(&Vh[(long)((k0) + 32 + sr) * LDV + sc]); \
    sr_[i].ks0 = LD8(&Kh[(long)((k0) + sr) * LDK + sc]); sr_[i].ks1 = LD8(&Kh[(long)((k0) + 32 + sr) * LDK + sc]); } while (0)
#define SWRITE(b, i) do { *(bf16x8*)((char*)V_lds + (b) * SHM_V + vst0) = sr_[i].vs0;          \
    *(bf16x8*)((char*)V_lds + (b) * SHM_V + vst1) = sr_[i].vs1; int kc = sc * 2;               \
    *(bf16x8*)((char*)K_lds + (b) * SHM_K + KSWZ(sr, kc)) = sr_[i].ks0;                       \
    *(bf16x8*)((char*)K_lds + (b) * SHM_K + KSWZ(32 + sr, kc)) = sr_[i].ks1; } while (0)
#define SWAIT() asm volatile("s_waitcnt vmcnt(4)" ::: "memory")
#define RESC(a) do { if (__any((a) < 1.f)) { if (hi == 0) al_l[r32] = (a); asm volatile("s_waitcnt lgkmcnt(0)" ::: "memory"); \
    for (int d = 0; d < 4; ++d) for (int r = 0; r < 16; ++r) o[d][r] *= al_l[crow(r, hi)]; } } while (0)
  f32x16 pA0, pA1, pB0, pB1; float mnA, mnB, alA, alB; bf16x8 pa0, pa1, pa2, pa3; const int NT = seq / KVBLK;
  constexpr int SE = 0, SO = 1;
  SLOAD(SE, 0); asm volatile("s_waitcnt vmcnt(0)" ::: "memory"); SWRITE(0, SE); __syncthreads();
  qkt(pA0, pA1, K_lds, qr, r32, hi); partialSM(pA0, pA1, m_reg, mnA, alA);
  SLOAD(SO, KVBLK); if (2 < NT) SLOAD(SE, 2 * KVBLK);
  SWAIT(); SWRITE(1, SO); __syncthreads();
  for (int j = 1; j + 1 < NT; j += 2) {
    SBAR(); qkt(pB0, pB1, (bf16_t*)((char*)K_lds + SHM_K), qr, r32, hi);
    finishSM(pA0, pA1, alA, l_reg, pa0, pa1, pa2, pa3); SBAR();
    SLOAD(SO, (j + 2) * KVBLK); SBAR();
    pv_d0(o, vb0, pa0, pa1, pa2, pa3); partialSM(pB0, pB1, m_reg, mnB, alB);
    __syncthreads(); SWAIT(); SWRITE(0, SE);
    RESC(alB); __syncthreads();
    SBAR(); qkt(pA0, pA1, K_lds, qr, r32, hi);
    finishSM(pB0, pB1, alB, l_reg, pa0, pa1, pa2, pa3); SBAR();
    if (j + 3 < NT) SLOAD(SE, (j + 3) * KVBLK); SBAR();
    pv_d0(o, vb0 + (int)SHM_V, pa0, pa1, pa2, pa3); partialSM(pA0, pA1, m_reg, mnA, alA);
    __syncthreads(); SWAIT(); SWRITE(1, SO);
    RESC(alA); __syncthreads();
  }
  SBAR(); qkt(pB0, pB1, (bf16_t*)((char*)K_lds + SHM_K), qr, r32, hi);
  finishSM(pA0, pA1, alA, l_reg, pa0, pa1, pa2, pa3); SBAR();
  pv_d0(o, vb0, pa0, pa1, pa2, pa3); partialSM(pB0, pB1, m_reg, mnB, alB);
  __syncthreads(); RESC(alB);
  finishSM(pB0, pB1, alB, l_reg, pa0, pa1, pa2, pa3); SBAR();
  pv_d0(o, vb0 + (int)SHM_V, pa0, pa1, pa2, pa3);
  if (hi == 0) li_l[r32] = l_reg; asm volatile("s_waitcnt lgkmcnt(0)" ::: "memory");
  float rli[16];
#pragma unroll
  for (int r = 0; r < 16; ++r) rli[r] = __builtin_amdgcn_rcpf(li_l[crow(r, hi)]);
  bf16_t* Ow = Ob + (long)(wid * QBLK) * LDO;
#pragma unroll
  for (int r = 0; r < 16; ++r) { int orow = crow(r, hi);
    for (int d0 = 0; d0 < 4; ++d0) Ow[(long)orow * LDO + d0 * 32 + r32] = (bf16_t)(cvtpk(o[d0][r] * rli[r], 0.f) & 0xffffu); }
#undef SLOAD
#undef SWRITE
#undef SWAIT
#undef RESC
#undef LD8
}
}
#define XB_TMO      128
#define XB_XCNT(j)  (256  + 64 * (j))
#define XB_XSUB(j)  (1280 + 64 * (j))
#define XB_XGEN(j)  (2304 + 64 * (j))
#define XB_TOP      3328
#define XB_TOPGEN   3392
#define XCD_BAR_WORDS 3456
#define XB_SPIN_CAP (1u << 18)

__device__ __forceinline__ unsigned xb_ld(unsigned* p)              { return __hip_atomic_load(p, __ATOMIC_RELAXED, __HIP_MEMORY_SCOPE_AGENT); }
__device__ __forceinline__ unsigned xb_add(unsigned* p, unsigned v) { return __hip_atomic_fetch_add(p, v, __ATOMIC_RELAXED, __HIP_MEMORY_SCOPE_AGENT); }
__device__ __forceinline__ unsigned xb_xcc_id() { return (unsigned)__builtin_amdgcn_s_getreg((3 << 11) | 20) & 0xFu; }
#define XB_SPIN(cond, bar) do { unsigned _sp = 0; while (cond) { __builtin_amdgcn_s_sleep(1); \
    if ((++_sp & 255u) == 0u) { if (xb_ld(&(bar)[XB_TMO])) break; if (_sp > XB_SPIN_CAP) { atomicAdd(&(bar)[XB_TMO], 1u); break; } } } } while (0)

struct XcdBarrier {
    unsigned* bar; unsigned x;
    volatile LAS unsigned* st;
};

__device__ __forceinline__ XcdBarrier xcd_barrier_post(unsigned* bar, volatile LAS unsigned* st) {
    XcdBarrier b; b.bar = bar; b.x = xb_xcc_id(); b.st = st;
    if (threadIdx.x == 0) (void)xb_add(&bar[XB_XCNT(b.x)], 1u);
    return b;
}
__device__ __forceinline__ void xcd_barrier_complete(unsigned* bar, unsigned x, unsigned& nloc, unsigned& nx) {
    const unsigned G = gridDim.x * gridDim.y * gridDim.z;
    unsigned sum, cnt, mine, sp = 0u;
    for (;;) {
        sum = 0u; cnt = 0u; mine = 0u;
#pragma unroll
        for (unsigned j = 0; j < 16; ++j) { const unsigned c = xb_ld(&bar[XB_XCNT(j)]); sum += c; cnt += (c > 0u) ? 1u : 0u; mine = (j == x) ? c : mine; }
        if (sum == G) break;
        __builtin_amdgcn_s_sleep(1);
        if ((++sp & 255u) == 0u) { if (xb_ld(&bar[XB_TMO])) break; if (sp > XB_SPIN_CAP) { atomicAdd(&bar[XB_TMO], 1u); break; } }
    }
    nloc = mine > 0u ? mine : 1u; nx = cnt > 0u ? cnt : 1u;
}

__device__ __forceinline__ void xcd_barrier(const XcdBarrier& b) {
    asm volatile("s_waitcnt vmcnt(0)" ::: "memory");
    __syncthreads();
    if (threadIdx.x == 0) {
        unsigned* bar = b.bar;
        __builtin_amdgcn_s_waitcnt(0);
        unsigned nloc = b.st[0], nx = b.st[1];
        if (nloc == 0u) { xcd_barrier_complete(bar, b.x, nloc, nx); b.st[0] = nloc; b.st[1] = nx; }
        const unsigned old = xb_add(&bar[XB_XSUB(b.x)], 1u);
        const unsigned gen = old / nloc;
        if (old + 1u == (gen + 1u) * nloc) {
            __builtin_amdgcn_fence(__ATOMIC_RELEASE, "agent");
            asm volatile("s_waitcnt vmcnt(0)" ::: "memory");
            const unsigned og = xb_add(&bar[XB_TOP], 1u);
            const unsigned tg = og / nx;
            if (og + 1u == (tg + 1u) * nx) xb_add(&bar[XB_TOPGEN], 1u);
            else XB_SPIN(xb_ld(&bar[XB_TOPGEN]) == tg, bar);
            __builtin_amdgcn_fence(__ATOMIC_ACQUIRE, "agent");
            xb_add(&bar[XB_XGEN(b.x)], 1u);
            asm volatile("s_waitcnt vmcnt(0)" ::: "memory");
        } else {
            XB_SPIN(xb_ld(&bar[XB_XGEN(b.x)]) == gen, bar);
            __builtin_amdgcn_fence(__ATOMIC_ACQUIRE, "agent");
            asm volatile("s_waitcnt vmcnt(0)" ::: "memory");
        }
    }
    __syncthreads();
}

constexpr size_t O_BAR = 512 * 1024;
enum { K_STORE = 1, K_SOFTMAX, K_SWIGLU, K_RESID, K_LN, K_H1, K_HSCAN, K_H2, K_HCOMB, K_PREP, K_ATTN };
constexpr unsigned long long PROG_EVEN = 0x1ull | (0x6ull << 4) | (0x7ull << 8) | (0x8ull << 12) | (0x9ull << 16) | (0x4ull << 20) | (0x5ull << 24) | (0x1ull << 28) | (0x2ull << 32) | (0x1ull << 36) |
                                         (0x4ull << 40) | (0x5ull << 44) | (0x3ull << 48) | (0x4ull << 52) | (0x5ull << 56);
constexpr unsigned long long PROG_ODD = 0x1ull | (0xAull << 4) | (0xBull << 8) | (0x4ull << 12) | (0x5ull << 16) | (0x1ull << 20) | (0x2ull << 24) | (0x1ull << 28) | (0x4ull << 32) | (0x5ull << 36) |
                                        (0x3ull << 40) | (0x4ull << 44) | (0x5ull << 48);

__global__ void __launch_bounds__(512, 2) mega(Args a_unused) {
    extern __shared__ __attribute__((aligned(16))) unsigned char lds_raw[];
    LAS unsigned char* lds = (LAS unsigned char*)lds_raw;
    cg::grid_group grid = cg::this_grid();
    const int G = gridDim.x, bx = blockIdx.x;
    const KArgP ap0 = (KArgP)__builtin_amdgcn_kernarg_segment_ptr();
#define KA() ({ KArgP _p = ap0; asm volatile("" : "+s"(_p)); _p; })
#define PTR(T, off) ((T*)(ws + (off)))
    prologue(KA(), lds, G);
    { unsigned* bw = (unsigned*)(KA()->ws + O_BAR); if (bx == 0) for (int i = threadIdx.x; i < XCD_BAR_WORDS; i += 512) bw[i] = 0u;
      if (threadIdx.x < 2) ((LAS unsigned*)(lds + LDS_BYTES - 16))[threadIdx.x] = 0u; }
    grid.sync();
    const XcdBarrier bar = xcd_barrier_post((unsigned*)(KA()->ws + O_BAR), (volatile LAS unsigned*)(lds + LDS_BYTES - 16));

    for (int l = 0; l < 4; ++l) {
        const int j = l >> 1; const bool odd = l & 1;
        const unsigned long long prog = odd ? PROG_ODD : PROG_EVEN; const int nsteps = odd ? 13 : 15;
        int n_store = 0, n_resid = 0, n_ln = 0;
        for (int st = 0; st < nsteps; ++st) {
            const int kind = (int)((prog >> (4 * st)) & 15ull);
            const KArgP ap = KA(); unsigned char* const ws = ap->ws;
            bf16_t* const Hb = PTR(bf16_t, O_H);
            if (kind == K_STORE) {
                const int nsub = (l == 0 && n_store == 0) ? 9 : 1;
                for (int sub = 0; sub < nsub; ++sub) {
                    pg8::Gemm g; pg8::EpiStore E; int c = bx;
                    if (sub == 0) {
                        if (n_store == 0) {
                            if (!odd) { g = pg8::Gemm{PTR(bf16_t, O_XN), PTR(const bf16_t, O_WAB) + (size_t)j * 3072 * 1024, M, 3072, 1024, 1024, 1024, 0, 256 * 1024}; E = pg8::EpiStore{Hb, 3072, 512, 1.f}; }
                            else      { g = pg8::Gemm{PTR(bf16_t, O_XN), PTR(const bf16_t, O_WCD) + (size_t)j * 2048 * 1024, M, 2048, 1024, 1024, 1024, 0, 256 * 1024}; E = pg8::EpiStore{Hb, 2048, 0, 1.f}; }
                        } else if (n_store == 1) {
                            g = pg8::Gemm{PTR(bf16_t, O_XN), PTR(const bf16_t, O_WQ) + (size_t)l * 1024 * 1024, M, 1024, 1024, 1024, 1024, 0, 256 * 1024}; E = pg8::EpiStore{Hb, 1024, 0, 0.0625f * 1.4426950408889634f};
                        } else {
                            g = pg8::Gemm{Hb + (size_t)M * 1024, PTR(const bf16_t, O_XVT) + (size_t)l * 1024 * 256, M, 1024, 256, 1024, 256, 256, 256 * 256}; E = pg8::EpiStore{Hb + 2 * (size_t)M * 1024, 1024, 0, 1.f};
                        }
                    } else if (sub <= 4) {
                        const int ll = sub - 1; c = (bx + G - 4 * sub) % G;
                        g = pg8::Gemm{PTR(const bf16_t, O_MEMB), PTR(const bf16_t, O_WKV) + (size_t)ll * 2048 * 1024, 256, 1024, 1024, 1024, 1024, 0, 256 * 1024}; E = pg8::EpiStore{PTR(bf16_t, O_XK) + (size_t)ll * 256 * 1024, 1024, 0, 1.f};
                    } else {
                        const int ll = sub - 5; c = (bx + G - 4 * sub) % G;
                        g = pg8::Gemm{PTR(const bf16_t, O_WKV) + (size_t)ll * 2048 * 1024 + (size_t)1024 * 1024, PTR(const bf16_t, O_MEMB), 1024, 256, 1024, 1024, 1024, 0, 256 * 1024}; E = pg8::EpiStore{PTR(bf16_t, O_XVT) + (size_t)ll * 1024 * 256, 256, 0, 1.f};
                    }
                    pg8::StaticOrder S; S.init(g.M, g.N, G, c);
                    pg8::gemm_phase<pg8::EpiStore, pg8::StaticOrder, true, true>(lds, g, S, E);
                }
                ++n_store;
            } else if (kind == K_SOFTMAX) {
                pg8::Gemm g{Hb, PTR(const bf16_t, O_XK) + (size_t)l * 256 * 1024, M, 1024, 256, 1024, 1024, 256, 256};
                pg8::EpiSoftmax E{Hb + (size_t)M * 1024}; pg8::StaticOrder S; S.init(M, 1024, G, bx);
                pg8::gemm_phase<pg8::EpiSoftmax, pg8::StaticOrder, false, true>(lds, g, S, E);
            } else if (kind == K_SWIGLU) {
                pg8::Gemm g{PTR(bf16_t, O_XN), PTR(const bf16_t, O_WGU) + (size_t)l * 5632 * 1024, M, 5632, 1024, 1024, 1024, 0, 256 * 1024};
                pg8::EpiSwiGLU E{Hb, DFF}; pg8::StaticOrder S; S.init(M, 5632, G, bx);
                pg8::gemm_phase<pg8::EpiSwiGLU, pg8::StaticOrder, true, true>(lds, g, S, E);
            } else if (kind == K_RESID) {
                pg8::Gemm g;
                if (n_resid == 0) g = pg8::Gemm{PTR(bf16_t, O_CAT), PTR(const bf16_t, (odd ? O_WOCD : O_WOAB)) + (size_t)j * 1024 * 1024, M, 1024, 1024, 1024, 1024, 0, 256 * 1024};
                else if (n_resid == 1) g = pg8::Gemm{Hb + 2 * (size_t)M * 1024, PTR(const bf16_t, O_WO) + (size_t)l * 1024 * 1024, M, 1024, 1024, 1024, 1024, 0, 256 * 1024};
                else g = pg8::Gemm{Hb, PTR(const bf16_t, O_WDN) + (size_t)l * 1024 * 2816, M, 1024, 2816, 2816, 2816, 0, 256 * 2816};
                pg8::EpiResid E{(l == 0 && n_resid == 0) ? ap->in[0] : ap->out, ap->out, ALPHA}; pg8::StaticOrder S; S.init(M, 1024, G, bx);
                pg8::gemm_phase<pg8::EpiResid, pg8::StaticOrder, true, true>(lds, g, S, E);
                ++n_resid;
            } else if (kind == K_LN) {
                ln_phase(ap->out, PTR(bf16_t, O_XN), ap->in[21] + (size_t)(l * 3 + n_ln) * 1024, ap->in[22] + (size_t)(l * 3 + n_ln) * 1024, G);
                ++n_ln;
            } else if (kind == K_H1) {
                for (int it = bx; it < 256; it += G) hgrn_item<false>(lds, Hb, PTR(float, O_CTL), l, it >> 7, (it >> 5) & 3, it & 31, PTR(float, O_ST), PTR(float, O_CTL + 65536), nullptr);
            } else if (kind == K_HSCAN) {
                hgrn_scan(PTR(float, O_ST), PTR(float, O_CTL + 65536), G);
            } else if (kind == K_H2) {
                for (int it = bx; it < 256; it += G) hgrn_item<true>(lds, Hb, PTR(float, O_CTL), l, it >> 7, (it >> 5) & 3, it & 31, PTR(float, O_ST), PTR(float, O_CTL + 65536), (it >> 7) ? PTR(float, O_XN) : PTR(float, O_OF));
            } else if (kind == K_HCOMB) {
                hcomb_pool(Hb, PTR(float, O_OF), PTR(float, O_XN), ap->in[4] + (size_t)j * 512, PTR(bf16_t, O_CAT), G);
            } else if (kind == K_PREP) {
                conv_items(lds, Hb, ap->in[11] + (size_t)j * 31 * 512, ap->in[12] + (size_t)j * 512, ap->in[13] + (size_t)j * 512, ap->in[14] + (size_t)j * 512, PTR(bf16_t, O_CAT), G);
                qk_prep(Hb, ap->in[9] + (size_t)j * 128, ap->in[10] + (size_t)j * 128, PTR(bf16_t, O_OF), PTR(bf16_t, O_OF) + (size_t)M * 512, G);
            } else if (kind == K_ATTN) {
                for (int u = bx; u < 256; u += G) { const int h = u & 3, qb = u >> 2, kvh = h >> 1;
                    att::attn_dense_body(PTR(bf16_t, O_OF) + (size_t)qb * 256 * 512 + h * 128, PTR(bf16_t, O_OF) + (size_t)M * 512 + kvh * 128, Hb + 768 + kvh * 128, PTR(bf16_t, O_CAT) + (size_t)qb * 256 * 1024 + h * 128, M, (char*)lds_raw);
                    __syncthreads(); }
            }
            xcd_barrier(bar);
        }
    }
}

extern "C" void kernel_launch(void* const* d_in, const int* in_sizes, int n_in, void* d_out, int out_size, void* d_ws, size_t ws_size, hipStream_t stream) {
    static int grid = 0;
    if (grid == 0) {
        if (n_in != 23 || out_size != M * DM || ws_size < O_END) { fprintf(stderr, "kernel_launch: unexpected shapes: n_in %d out %d ws %zu (need %zu)\n", n_in, out_size, ws_size, (size_t)O_END); grid = -1; return; }
        if (hipFuncSetAttribute((const void*)mega, hipFuncAttributeMaxDynamicSharedMemorySize, LDS_BYTES) != hipSuccess) { fprintf(stderr, "kernel_launch: hipFuncSetAttribute failed\n"); grid = -1; return; }
        int dev = 0, cus = 0, per = 0;
        if (hipGetDevice(&dev) != hipSuccess || hipDeviceGetAttribute(&cus, hipDeviceAttributeMultiprocessorCount, dev) != hipSuccess) { grid = -1; return; }
        if (hipOccupancyMaxActiveBlocksPerMultiprocessor(&per, (const void*)mega, 512, LDS_BYTES) != hipSuccess || per < 1) { fprintf(stderr, "kernel_launch: occupancy query says %d\n", per); (void)hipGetLastError(); }
        grid = cus;
        if (grid != 256) fprintf(stderr, "kernel_launch: %d CUs; this kernel expects 256\n", grid);
    }
    if (grid < 0) return;
    Args a{};
    for (int i = 0; i < 23; ++i) a.in[i] = (const float*)d_in[i];
    a.out = (float*)d_out; a.ws = (unsigned char*)d_ws;
    void* args[] = {&a};
    hipError_t e = hipLaunchCooperativeKernel((const void*)mega, dim3(grid), dim3(512), args, LDS_BYTES, stream);
    if (e != hipSuccess) fprintf(stderr, "kernel_launch: cooperative launch failed: %s\n", hipGetErrorString(e));
}
```
